# Optimizing an MI355X kernel written in HIP

```python
import math
import jax
import jax.numpy as jnp
from jax import lax
import numpy as np

D_MODEL = 1024
BATCH = 4
SEQ = 8192
DEPTH = 4

CHUNK = 64
N_EVEN = (DEPTH + 1) // 2
N_ODD = DEPTH // 2
RMS_EPS = 1e-6

DIFF_HEADS = 4
DIFF_HEAD_DIM = 64
DIFF_V_DIM = 2 * DIFF_HEAD_DIM
DIFF_WIDTH = DIFF_HEADS * DIFF_V_DIM
Q_BLOCK = 128

POOL_WINDOWS = (2, 4, 8, 16)
POOL_GROUPS = len(POOL_WINDOWS)
POOL_WIDTH = D_MODEL // 2
POOL_GROUP_DIM = POOL_WIDTH // POOL_GROUPS
AB_IN_WIDTH = 3 * DIFF_WIDTH + POOL_WIDTH
AB_OUT_IN = DIFF_WIDTH + POOL_WIDTH

GLA_HEADS = 4
GLA_KEY_DIM = D_MODEL // 2
GLA_VAL_DIM = D_MODEL
GLA_HK = GLA_KEY_DIM // GLA_HEADS
GLA_HV = GLA_VAL_DIM // GLA_HEADS
GLA_GATE_RANK = 16
GLA_GATE_TEMP = 16.0
GLA_IN_WIDTH = 2 * GLA_KEY_DIM + 2 * GLA_VAL_DIM + GLA_GATE_RANK

D_FF = 4 * D_MODEL

kernel_name = 'hybrid_diffattn_pool_gla_encoder'


def _rmsnorm(x, gain):
    xf = x.astype(jnp.float32)
    y = xf * lax.rsqrt(jnp.mean(xf * xf, axis=-1, keepdims=True) + RMS_EPS)
    return (y * gain.astype(jnp.float32)).astype(x.dtype)


def _lambda_init(layer_idx):
    return 0.8 - 0.6 * math.exp(-0.3 * layer_idx)


def _diff_attention(q, k, v, lam_params, subln_gain, layer_idx):
    bsz, seq, _ = q.shape
    q = q.reshape(bsz, seq, DIFF_HEADS, 2, DIFF_HEAD_DIM)
    k = k.reshape(bsz, seq, DIFF_HEADS, 2, DIFF_HEAD_DIM)
    q1 = q[:, :, :, 0].transpose(0, 2, 1, 3)
    q2 = q[:, :, :, 1].transpose(0, 2, 1, 3)
    k1 = k[:, :, :, 0].transpose(0, 2, 1, 3)
    k2 = k[:, :, :, 1].transpose(0, 2, 1, 3)
    v = v.reshape(bsz, seq, DIFF_HEADS, DIFF_V_DIM).transpose(0, 2, 1, 3)
    lam_p = lam_params.astype(jnp.float32)
    lam_init = _lambda_init(layer_idx)
    lam = jnp.exp(jnp.sum(lam_p[0] * lam_p[1])) - jnp.exp(jnp.sum(lam_p[2] * lam_p[3])) + lam_init
    n_blk = seq // Q_BLOCK

    def to_blocks(t):
        return t.reshape(bsz, DIFF_HEADS, n_blk, Q_BLOCK, DIFF_HEAD_DIM).transpose(2, 0, 1, 3, 4)

    key_chunk = jnp.arange(seq) // CHUNK
    scale = DIFF_HEAD_DIM ** -0.5

    def one_block(args):
        q1_b, q2_b, blk = args
        query_chunk = (blk * Q_BLOCK + jnp.arange(Q_BLOCK)) // CHUNK
        mask = key_chunk[None, :] <= query_chunk[:, None]
        s1 = jnp.einsum('bhqd,bhkd->bhqk', q1_b, k1).astype(jnp.float32) * scale
        s2 = jnp.einsum('bhqd,bhkd->bhqk', q2_b, k2).astype(jnp.float32) * scale
        p1 = jax.nn.softmax(jnp.where(mask, s1, -jnp.inf), axis=-1)
        p2 = jax.nn.softmax(jnp.where(mask, s2, -jnp.inf), axis=-1)
        p = p1 - lam * p2
        return jnp.einsum('bhqk,bhkv->bhqv', p.astype(v.dtype), v)

    o = lax.map(one_block, (to_blocks(q1), to_blocks(q2), jnp.arange(n_blk)))
    o = o.transpose(1, 2, 0, 3, 4).reshape(bsz, DIFF_HEADS, seq, DIFF_V_DIM)
    o = _rmsnorm(o, subln_gain) * (1.0 - lam_init)
    return o.transpose(0, 2, 1, 3).reshape(bsz, seq, DIFF_WIDTH)


def _pool_mixer(u, pool_w, pool_scale):
    bsz, seq, _ = u.shape
    u = u.reshape(bsz, seq, POOL_GROUPS, POOL_GROUP_DIM)
    pos = jnp.arange(seq)
    outs = []
    for g, w in enumerate(POOL_WINDOWS):
        ug = u[:, :, g].astype(jnp.float32)
        cs = jnp.cumsum(ug, axis=1)
        lagged = jnp.pad(cs, ((0, 0), (w, 0), (0, 0)))[:, :seq]
        count = jnp.minimum(pos + 1, w).astype(jnp.float32)
        outs.append((cs - lagged) / count[None, :, None] - ug)
    r = jnp.stack(outs, axis=2).astype(u.dtype)
    y = jnp.einsum('bsgc,gcd->bsgd', r, pool_w) * pool_scale.reshape(POOL_GROUPS, POOL_GROUP_DIM)
    return y.reshape(bsz, seq, POOL_WIDTH)


def _gla_mixer(h, w_in, w_gk_up, b_gk, norm_gain, w_out):
    bsz, seq, _ = h.shape
    n_chunk = seq // CHUNK
    proj = h @ w_in
    q, k, v, g_out, gk_low = jnp.split(
        proj,
        [GLA_KEY_DIM, 2 * GLA_KEY_DIM, 2 * GLA_KEY_DIM + GLA_VAL_DIM, 2 * GLA_KEY_DIM + 2 * GLA_VAL_DIM],
        axis=-1)
    log_a = jax.nn.log_sigmoid((gk_low @ w_gk_up + b_gk).astype(jnp.float32)) / GLA_GATE_TEMP

    def to_chunks(t, d):
        return t.reshape(bsz, n_chunk, CHUNK, GLA_HEADS, d).transpose(1, 0, 3, 2, 4)

    qc = to_chunks(q * (GLA_HK ** -0.5), GLA_HK)
    kc = to_chunks(k, GLA_HK)
    vc = to_chunks(v, GLA_HV)
    gc = to_chunks(log_a, GLA_HK)
    causal = jnp.tril(jnp.ones((CHUNK, CHUNK), dtype=bool))

    def step(state, inp):
        qi, ki, vi, gi = inp
        qi = qi.astype(jnp.float32)
        ki = ki.astype(jnp.float32)
        vi = vi.astype(jnp.float32)
        b = jnp.cumsum(gi, axis=2)
        o_inter = jnp.einsum('bhlk,bhkv->bhlv', qi * jnp.exp(b), state)
        diff = b[:, :, :, None, :] - b[:, :, None, :, :]
        decay = jnp.exp(jnp.where(causal[:, :, None], diff, -jnp.inf))
        attn = jnp.einsum('bhijk,bhjk->bhij', qi[:, :, :, None, :] * decay, ki)
        o_intra = jnp.einsum('bhij,bhjv->bhiv', attn, vi)
        b_last = b[:, :, -1:, :]
        new_state = (jnp.exp(b_last[:, :, 0, :])[..., None] * state
                     + jnp.einsum('bhlk,bhlv->bhkv', ki * jnp.exp(b_last - b), vi))
        return new_state, o_inter + o_intra

    state0 = jnp.zeros((bsz, GLA_HEADS, GLA_HK, GLA_HV), jnp.float32)
    _, o = lax.scan(step, state0, (qc, kc, vc, gc))
    o = o.transpose(1, 0, 3, 2, 4).reshape(bsz, seq, GLA_HEADS, GLA_HV).astype(h.dtype)
    gate = jax.nn.silu(g_out).reshape(bsz, seq, GLA_HEADS, GLA_HV)
    o = _rmsnorm(o, norm_gain) * gate
    return o.reshape(bsz, seq, GLA_VAL_DIM) @ w_out


def setup_inputs(seed: int = 0) -> dict:
    key = jax.random.key(seed)
    ks = jax.random.split(key, 17)
    f32 = jnp.float32

    def nrm(k, shape, scale):
        return jax.random.normal(k, shape, f32) * scale

    return {
        'x': nrm(ks[0], (BATCH, SEQ, D_MODEL), 1.0),
        'norm_mix': 1.0 + nrm(ks[1], (DEPTH, D_MODEL), 0.02),
        'norm_ffn': 1.0 + nrm(ks[2], (DEPTH, D_MODEL), 0.02),
        'norm_final': 1.0 + nrm(ks[3], (D_MODEL,), 0.02),
        'ab_w_in': nrm(ks[4], (N_EVEN, D_MODEL, AB_IN_WIDTH), D_MODEL ** -0.5),
        'ab_lambda': nrm(ks[5], (N_EVEN, 4, DIFF_HEAD_DIM), 0.1),
        'ab_subln': 1.0 + nrm(ks[6], (N_EVEN, DIFF_V_DIM), 0.02),
        'pool_w': nrm(ks[7], (N_EVEN, POOL_GROUPS, POOL_GROUP_DIM, POOL_GROUP_DIM), POOL_GROUP_DIM ** -0.5),
        'pool_scale': 1.0 + nrm(ks[8], (N_EVEN, POOL_WIDTH), 0.1),
        'ab_w_out': nrm(ks[9], (N_EVEN, AB_OUT_IN, D_MODEL), AB_OUT_IN ** -0.5),
        'gla_w_in': nrm(ks[10], (N_ODD, D_MODEL, GLA_IN_WIDTH), D_MODEL ** -0.5),
        'gla_w_gk_up': nrm(ks[11], (N_ODD, GLA_GATE_RANK, GLA_KEY_DIM), GLA_GATE_RANK ** -0.5),
        'gla_b_gk': nrm(ks[12], (N_ODD, GLA_KEY_DIM), 0.1),
        'gla_norm': 1.0 + nrm(ks[13], (N_ODD, GLA_HEADS, GLA_HV), 0.02),
        'gla_w_out': nrm(ks[14], (N_ODD, GLA_VAL_DIM, D_MODEL), GLA_VAL_DIM ** -0.5),
        'ffn_w1': nrm(ks[15], (DEPTH, D_MODEL, D_FF), D_MODEL ** -0.5),
        'ffn_w2': nrm(ks[16], (DEPTH, D_FF, D_MODEL), D_FF ** -0.5),
    }


def reference(x, norm_mix, norm_ffn, norm_final, ab_w_in, ab_lambda, ab_subln, pool_w, pool_scale,
              ab_w_out, gla_w_in, gla_w_gk_up, gla_b_gk, gla_norm, gla_w_out, ffn_w1, ffn_w2):
    for i in range(DEPTH):
        h = _rmsnorm(x, norm_mix[i])
        if i % 2 == 0:
            e = i // 2
            proj = h @ ab_w_in[e]
            q, k, v, u = jnp.split(proj, [DIFF_WIDTH, 2 * DIFF_WIDTH, 3 * DIFF_WIDTH], axis=-1)
            a_out = _diff_attention(q, k, v, ab_lambda[e], ab_subln[e], i)
            b_out = _pool_mixer(u, pool_w[e], pool_scale[e])
            x = x + jnp.concatenate([a_out, b_out], axis=-1) @ ab_w_out[e]
        else:
            o = i // 2
            x = x + _gla_mixer(h, gla_w_in[o], gla_w_gk_up[o], gla_b_gk[o], gla_norm[o], gla_w_out[o])
        h = _rmsnorm(x, norm_ffn[i])
        x = x + jnp.square(jax.nn.relu(h @ ffn_w1[i])) @ ffn_w2[i]
    return _rmsnorm(x, norm_final)
```

```cpp
#include <hip/hip_runtime.h>
#include <hip/hip_cooperative_groups.h>
#include <cstdio>
#include <cstdint>
namespace cg = cooperative_groups;
namespace pg8 {
#define PG8_LAS __attribute__((address_space(3)))
typedef unsigned short bf16_t;
typedef short bf16x8 __attribute__((ext_vector_type(8)));
typedef float f32x4 __attribute__((ext_vector_type(4)));
typedef unsigned u32x4 __attribute__((ext_vector_type(4)));
constexpr int BM = 256, BK = 64, HALF = 128, HTB = HALF * BK * 2  , STAGE_BYTES = 8 * HTB, NXCD = 8, WGM = 8;

__host__ __device__ __forceinline__ int lds_byte(int r, int c) { const int st = (r >> 4) * 2 + (c >> 5), rr = r & 15, cc = c & 31, ob = rr * 64 + cc * 2; return st * 1024 + (ob ^ (((ob >> 9) & 1) << 5)); }
__host__ __device__ __forceinline__ void stage_rc(int b, int& R, int& C) { const int st = b / 1024, sb = b % 1024, swz = sb ^ (((sb >> 9) & 1) << 5); R = (st >> 1) * 16 + swz / 64; C = (st & 1) * 32 + (swz % 64) / 2; }
__host__ __device__ __forceinline__ int perm32(int rho) { const int n = rho >> 4, i = rho & 15; return 8 * (i >> 2) + 4 * n + (i & 3); }

struct Unit { int pm, pn; };
struct Gemm { const bf16_t* A; const bf16_t* Bt; int M, N, K; };

struct StaticOrder {
    int nM, nN, nwg, G, c;
    __host__ __device__ void init(int M, int N, int G_, int c_) { nM = M / BM; nN = N / BM; nwg = nM * nN; G = G_; c = c_; }
    __host__ __device__ bool next(int i, Unit& u) const {
        const long L = (long)i * G + c; if (L >= nwg) return false;
        int wgid = (int)L; { const int q = nwg / NXCD, r = nwg % NXCD, xcd = wgid % NXCD, off = wgid / NXCD; wgid = (xcd < r ? xcd * (q + 1) : r * (q + 1) + (xcd - r) * q) + off; }
        const int nig = WGM * nN, gid = wgid / nig, fm = gid * WGM, gsz = (nM - fm) < WGM ? (nM - fm) : WGM;
        u.pm = fm + ((wgid % nig) % gsz); u.pn = (wgid % nig) / gsz; return true;
    }
    __device__ __forceinline__ void a_ready(const Unit&) const {}
    __device__ __forceinline__ void done(const Unit&) const {}
};
__device__ __forceinline__ unsigned cvt_pk_bf16(float lo, float hi) { unsigned r; asm volatile("v_cvt_pk_bf16_f32 %0, %1, %2" : "=v"(r) : "v"(lo), "v"(hi)); return r; }
typedef float f32x2 __attribute__((ext_vector_type(2)));
template <class Epi, class Sched, bool ALIGN_EPI = false, bool SP2 = false>
__device__ __forceinline__ void gemm_phase(PG8_LAS unsigned char* lds, const Gemm g, const Sched& S, const Epi& E) {
    int tid_ = threadIdx.x; asm volatile("" : "+v"(tid_));
    const int tid = tid_, wid = __builtin_amdgcn_readfirstlane(tid >> 6), lane = tid & 63, wr = wid >> 2, wc = wid & 3, fr = lane & 15, fq = lane >> 4;
    const int K = g.K, nt = K / BK;
    unsigned voffA[2], voffB[2];
#pragma unroll
    for (int i = 0; i < 2; ++i) { int R, C; stage_rc(tid * 16 + i * 8192, R, C); const int Rb = Epi::PERM ? ((R & ~31) + perm32(R & 31)) : R;
        voffA[i] = (unsigned)(R * K + C) * 2u; voffB[i] = (unsigned)(Rb * K + C) * 2u; }
    const size_t kstep = (size_t)(BK * 2);
    const size_t hstep = (size_t)HALF * K * 2;
    const size_t tstep = 2 * hstep;
    const unsigned ldsw = (unsigned)wid * 1024u;
    const int aoff = lds_byte(wr * 64 + fr, fq * 8), boff = lds_byte(wc * 32 + fr, fq * 8);
#define PG8_SA(b, h) (((b) * 2 + (h)) * HTB)
#define PG8_SB(b, h) ((4 + (b) * 2 + (h)) * HTB)
#define PG8_STAGE(bufoff, gbase, voff) do { _Pragma("unroll") for (int _i = 0; _i < 2; ++_i) \
        __builtin_amdgcn_global_load_lds((const unsigned*)((const char*)(gbase) + (voff)[_i]), (PG8_LAS unsigned*)(lds + (bufoff) + ldsw + _i * 8192), 16, 0, 0); } while (0)
#define PG8_LDA(dst, b, h) do { _Pragma("unroll") for (int m = 0; m < 4; ++m) _Pragma("unroll") for (int k = 0; k < 2; ++k) dst[m][k] = *(const PG8_LAS bf16x8*)(lds + PG8_SA(b, h) + aoff + m * 2048 + k * 1024); } while (0)
#define PG8_LDB(dst, b, h) do { _Pragma("unroll") for (int n = 0; n < 2; ++n) _Pragma("unroll") for (int k = 0; k < 2; ++k) dst[n][k] = *(const PG8_LAS bf16x8*)(lds + PG8_SB(b, h) + boff + n * 2048 + k * 1024); } while (0)
#define PG8_MMA(ai, bj, At, Bt) do { __builtin_amdgcn_s_setprio(1); _Pragma("unroll") for (int m = 0; m < 4; ++m) _Pragma("unroll") for (int n = 0; n < 2; ++n) _Pragma("unroll") for (int k = 0; k < 2; ++k) \
        acc[ai][bj][m][n] = __builtin_amdgcn_mfma_f32_16x16x32_bf16(Bt[n][k], At[m][k], acc[ai][bj][m][n], 0, 0, 0); __builtin_amdgcn_s_setprio(0); } while (0)
#define PG8_WAIT_V(n) asm volatile("s_waitcnt vmcnt(" #n ")" ::: "memory")
#define PG8_WAIT_L(n) asm volatile("s_waitcnt lgkmcnt(" #n ")" ::: "memory")
#define PG8_BAR __builtin_amdgcn_s_barrier()
#define PG8_SCHED __builtin_amdgcn_sched_barrier(0)
    Unit cur, nxt; int ui = 0;
    if (!S.next(0, cur)) return;
    f32x4 acc[2][2][4][2];
#pragma unroll
    for (int a = 0; a < 2; ++a)
#pragma unroll
        for (int b = 0; b < 2; ++b)
#pragma unroll
            for (int m = 0; m < 4; ++m)
#pragma unroll
                for (int n = 0; n < 2; ++n) acc[a][b][m][n] = (f32x4){0.f, 0.f, 0.f, 0.f};
    bf16x8 At[4][2], B0[2][2], B1[2][2];
    const char* cA = (const char*)g.A + (size_t)cur.pm * tstep; const char* cB = (const char*)g.Bt + (size_t)cur.pn * tstep;
    S.a_ready(cur);
    if constexpr (SP2) {
        PG8_STAGE(PG8_SB(0, 0), cB, voffB); PG8_STAGE(PG8_SB(0, 1), cB + hstep, voffB); PG8_STAGE(PG8_SA(0, 0), cA, voffA); PG8_STAGE(PG8_SA(0, 1), cA + hstep, voffA);
        if (wr == 1) PG8_BAR;
        PG8_WAIT_V(2); PG8_BAR;
        PG8_STAGE(PG8_SB(1, 0), cB + kstep, voffB); PG8_STAGE(PG8_SA(1, 0), cA + kstep, voffA); PG8_STAGE(PG8_SB(1, 1), cB + hstep + kstep, voffB);
        PG8_WAIT_V(6); PG8_BAR;
    } else {
        PG8_STAGE(PG8_SB(0, 0), cB, voffB); PG8_STAGE(PG8_SA(0, 0), cA, voffA); PG8_STAGE(PG8_SB(0, 1), cB + hstep, voffB); PG8_STAGE(PG8_SA(0, 1), cA + hstep, voffA);
        if (wr == 1) PG8_BAR;
        PG8_WAIT_V(4); PG8_BAR;
        PG8_STAGE(PG8_SB(1, 0), cB + kstep, voffB); PG8_STAGE(PG8_SA(1, 0), cA + kstep, voffA); PG8_STAGE(PG8_SB(1, 1), cB + hstep + kstep, voffB);
        PG8_WAIT_V(6); PG8_BAR;
    }
    for (;;) {
        const bool has_next = S.next(ui + 1, nxt);
        const char* nA = has_next ? (const char*)g.A + (size_t)nxt.pm * tstep : cA; const char* nB = has_next ? (const char*)g.Bt + (size_t)nxt.pn * tstep : cB;
        for (int t = 0; t < nt; t += 2) {
            const bool last = (t == nt - 2);
            const char* a1 = cA + (size_t)(t + 1) * kstep;
            const char* a2 = last ? nA : cA + (size_t)(t + 2) * kstep; const char* b2 = last ? nB : cB + (size_t)(t + 2) * kstep;
            const char* a3 = a2 + kstep; const char* b3 = b2 + kstep;
            if (last && has_next) S.a_ready(nxt);
            if constexpr (SP2) {
            PG8_LDB(B0, 0, 0); PG8_LDB(B1, 0, 1); PG8_SCHED; PG8_LDA(At, 0, 0); PG8_STAGE(PG8_SA(1, 1), a1 + hstep, voffA);
            PG8_WAIT_V(8); PG8_WAIT_L(0); PG8_BAR; PG8_MMA(0, 0, At, B0); PG8_MMA(0, 1, At, B1); PG8_BAR; PG8_SCHED;
            PG8_LDA(At, 0, 1); PG8_STAGE(PG8_SB(0, 0), b2, voffB); PG8_STAGE(PG8_SB(0, 1), b2 + hstep, voffB); PG8_STAGE(PG8_SA(0, 0), a2, voffA);
            PG8_WAIT_V(8); PG8_WAIT_L(0); PG8_BAR; PG8_MMA(1, 0, At, B0); PG8_MMA(1, 1, At, B1); PG8_BAR; PG8_SCHED;
            PG8_LDB(B0, 1, 0); PG8_LDB(B1, 1, 1); PG8_SCHED; PG8_LDA(At, 1, 0); PG8_STAGE(PG8_SA(0, 1), a2 + hstep, voffA);
            PG8_WAIT_V(8); PG8_WAIT_L(0); PG8_BAR; PG8_MMA(0, 0, At, B0); PG8_MMA(0, 1, At, B1); PG8_BAR; PG8_SCHED;
            PG8_LDA(At, 1, 1); PG8_STAGE(PG8_SB(1, 0), b3, voffB); PG8_STAGE(PG8_SB(1, 1), b3 + hstep, voffB); PG8_STAGE(PG8_SA(1, 0), a3, voffA);
            PG8_WAIT_V(8); PG8_WAIT_L(0); PG8_BAR; PG8_MMA(1, 0, At, B0); PG8_MMA(1, 1, At, B1); PG8_BAR; PG8_SCHED;
            } else {
            PG8_LDB(B0, 0, 0); PG8_SCHED; PG8_LDA(At, 0, 0); PG8_STAGE(PG8_SA(1, 1), a1 + hstep, voffA);
            PG8_WAIT_L(8); PG8_BAR; PG8_WAIT_L(0); PG8_MMA(0, 0, At, B0); PG8_BAR; PG8_SCHED;
            PG8_LDB(B1, 0, 1); PG8_STAGE(PG8_SB(0, 0), b2, voffB);
            PG8_BAR; PG8_WAIT_L(0); PG8_MMA(0, 1, At, B1); PG8_BAR;
            PG8_LDA(At, 0, 1); PG8_STAGE(PG8_SA(0, 0), a2, voffA);
            PG8_BAR; PG8_WAIT_L(0); PG8_MMA(1, 0, At, B0); PG8_BAR; PG8_SCHED;
            PG8_STAGE(PG8_SB(0, 1), b2 + hstep, voffB);
            PG8_WAIT_V(6); PG8_BAR; PG8_MMA(1, 1, At, B1); PG8_BAR;
            PG8_LDB(B0, 1, 0); PG8_SCHED; PG8_LDA(At, 1, 0); PG8_STAGE(PG8_SA(0, 1), a2 + hstep, voffA);
            PG8_WAIT_L(8); PG8_BAR; PG8_WAIT_L(0); PG8_MMA(0, 0, At, B0); PG8_BAR; PG8_SCHED;
            PG8_LDB(B1, 1, 1); PG8_STAGE(PG8_SB(1, 0), b3, voffB);
            PG8_BAR; PG8_WAIT_L(0); PG8_MMA(0, 1, At, B1); PG8_BAR;
            PG8_LDA(At, 1, 1); PG8_STAGE(PG8_SA(1, 0), a3, voffA);
            PG8_BAR; PG8_WAIT_L(0); PG8_MMA(1, 0, At, B0); PG8_BAR; PG8_SCHED;
            PG8_STAGE(PG8_SB(1, 1), b3 + hstep, voffB);
            PG8_WAIT_V(6); PG8_BAR; PG8_MMA(1, 1, At, B1); PG8_BAR;
            }
        }
        if constexpr (ALIGN_EPI) { if (wr == 0) PG8_BAR; }
        if constexpr (!Epi::AFTER_DRAIN) { E(acc, cur, wr, wc, fr, fq); S.done(cur); }
        if (!has_next) break;
#pragma unroll
        for (int a = 0; a < 2; ++a)
#pragma unroll
            for (int b = 0; b < 2; ++b)
#pragma unroll
                for (int m = 0; m < 4; ++m)
#pragma unroll
                    for (int n = 0; n < 2; ++n) acc[a][b][m][n] = (f32x4){0.f, 0.f, 0.f, 0.f};
        cur = nxt; cA = nA; cB = nB; ++ui;
        if constexpr (ALIGN_EPI) { if (wr == 1) PG8_BAR; }
    }
    PG8_WAIT_V(0);
    if constexpr (!ALIGN_EPI) { if (wr == 0) PG8_BAR; }
    PG8_BAR;
    if constexpr (Epi::AFTER_DRAIN) { E.fused(acc, cur, wr, wc, fr, fq, lds, wid, lane); S.done(cur); }
#undef PG8_SA
#undef PG8_SB
#undef PG8_STAGE
#undef PG8_LDA
#undef PG8_LDB
#undef PG8_MMA
#undef PG8_WAIT_V
#undef PG8_WAIT_L
#undef PG8_BAR
#undef PG8_SCHED
}
}

#define LAS __attribute__((address_space(3)))
#define GAS __attribute__((address_space(1)))
typedef unsigned short bf16;
typedef short bf16x8 __attribute__((ext_vector_type(8)));
typedef float f32x4 __attribute__((ext_vector_type(4)));
typedef float f32x16 __attribute__((ext_vector_type(16)));
typedef unsigned u32x4 __attribute__((ext_vector_type(4)));
typedef unsigned u32x2 __attribute__((ext_vector_type(2)));
typedef short v4i16_t __attribute__((ext_vector_type(4)));
typedef float f32x2_t __attribute__((ext_vector_type(2)));
typedef __bf16 bf16x2_t __attribute__((ext_vector_type(2)));

constexpr int T_TOK = 32768, DM = 1024, SEQ = 8192, DFF = 4096;
constexpr int AB_N = 2048, GLA_N = 3088, GLA_NP = 3584;
constexpr float RMS_EPS = 1e-6f;
constexpr float QK_C2 = 0.125f * 1.4426950408889634f;
constexpr size_t MiB = 1u << 20;
constexpr size_t WS_WAB_IN = 0, WS_WAB_OUT = 8 * MiB, WS_WGLA_IN = 12 * MiB, WS_WGLA_OUT = 26 * MiB, WS_W1 = 30 * MiB, WS_W2 = 62 * MiB;
constexpr size_t WS_SSQ = 480 * MiB  , WS_DEC = 95 * MiB, WS_XB = 96 * MiB, WS_CAT = 160 * MiB, WS_R = 224 * MiB;
constexpr size_t WS_STASH = WS_R + 128 * MiB, WS_UHI = WS_R + 208 * MiB, WS_END = 496 * MiB;
constexpr size_t WS_CTL = 94 * MiB, CTL_BYTES = 16384;
constexpr int LDS_BYTES = 147456, LDS_BARST = 131072 + 1024;
constexpr int NSTEPS = 26;

__device__ __forceinline__ unsigned f2bf(float f) { unsigned u = __builtin_bit_cast(unsigned, f); return (u + 0x7fffu + ((u >> 16) & 1u)) >> 16; }
__device__ __forceinline__ unsigned pk2(float lo, float hi) { f32x2_t v = {lo, hi}; bf16x2_t b = __builtin_convertvector(v, bf16x2_t); return __builtin_bit_cast(unsigned, b); }
__device__ __forceinline__ float bf2f(unsigned short u) { return __builtin_bit_cast(float, (unsigned)u << 16); }
__device__ __forceinline__ float bflo(unsigned u) { return __builtin_bit_cast(float, u << 16); }
__device__ __forceinline__ float bfhi(unsigned u) { return __builtin_bit_cast(float, u & 0xffff0000u); }
__device__ __forceinline__ int crow(int r, int hi) { return (r & 3) + 8 * (r >> 2) + 4 * hi; }
__device__ __forceinline__ bf16x8 pack8(float a0, float a1, float a2, float a3, float a4, float a5, float a6, float a7) {
    u32x4 w; w.x = pk2(a0, a1); w.y = pk2(a2, a3); w.z = pk2(a4, a5); w.w = pk2(a6, a7); return __builtin_bit_cast(bf16x8, w);
}
__device__ __forceinline__ v4i16_t trrd(const LAS unsigned char* p) { return __builtin_amdgcn_ds_read_tr16_b64_v4i16((LAS v4i16_t*)p); }
__device__ __forceinline__ bf16x8 cat44(v4i16_t lo, v4i16_t hi) { return (bf16x8){lo[0], lo[1], lo[2], lo[3], hi[0], hi[1], hi[2], hi[3]}; }
template <class T> __device__ __forceinline__ T gld(const T* p) { return *(const GAS T*)p; }
template <class T> __device__ __forceinline__ void gst(T* p, T v) { *(GAS T*)p = v; }
#define MFMA32(a, b, c) __builtin_amdgcn_mfma_f32_32x32x16_bf16((a), (b), (c), 0, 0, 0)


__device__ __forceinline__ int otid() { int t = threadIdx.x; asm volatile("" : "+v"(t)); return t; }
template <class P> __device__ __forceinline__ P* optr(P* p) { asm volatile("" : "+s"(p)); return p; }
struct EpiX {
    static constexpr bool PERM = true, AFTER_DRAIN = false;
    int mode;
    bf16* O; int ldc;
    const float* ssq_in;
    const float* base; float* xout; float* ssq_out;
    __device__ __forceinline__ void operator()(const pg8::f32x4 (&acc)[2][2][4][2], const pg8::Unit& u, int wr, int wc, int fr, int fq) const {
        const int row0 = u.pm * 256 + wr * 64 + fr, col0 = u.pn * 256 + wc * 32 + 8 * fq;
        if (mode != 2) {
            const int lane = fq * 16 + fr;
            float rsv[2];
#pragma unroll
            for (int j = 0; j < 2; ++j) {
                const float* sp = ssq_in + (size_t)(u.pm * 256 + wr * 64 + j * 128 + lane) * 16;
                const f32x4 q0 = *(const GAS f32x4*)(sp), q1 = *(const GAS f32x4*)(sp + 4), q2 = *(const GAS f32x4*)(sp + 8), q3 = *(const GAS f32x4*)(sp + 12);
                const float tot = (((q0[0] + q0[1]) + (q0[2] + q0[3])) + ((q1[0] + q1[1]) + (q1[2] + q1[3]))) + (((q2[0] + q2[1]) + (q2[2] + q2[3])) + ((q3[0] + q3[1]) + (q3[2] + q3[3])));
                rsv[j] = rsqrtf(tot * (1.0f / 1024.0f) + RMS_EPS);
            }
#pragma unroll
            for (int ai = 0; ai < 2; ++ai)
#pragma unroll
                for (int m = 0; m < 4; ++m) {
                    const int row = row0 + ai * 128 + m * 16;
                    const float rs = __shfl(rsv[ai], m * 16 + fr);
#pragma unroll
                    for (int bj = 0; bj < 2; ++bj) {
                        f32x4 v0 = acc[ai][bj][m][0] * rs, v1 = acc[ai][bj][m][1] * rs;
                        if (mode == 1) {
#pragma unroll
                            for (int i = 0; i < 4; ++i) { float a = fmaxf(v0[i], 0.f), b = fmaxf(v1[i], 0.f); v0[i] = a * a; v1[i] = b * b; }
                        }
                        u32x4 w; w.x = pk2(v0[0], v0[1]); w.y = pk2(v0[2], v0[3]); w.z = pk2(v1[0], v1[1]); w.w = pk2(v1[2], v1[3]);
                        *(GAS u32x4*)(O + (size_t)row * ldc + col0 + bj * 128) = w;
                    }
                }
        } else {
#pragma unroll
            for (int ai = 0; ai < 2; ++ai) {
                u32x4 bb[4][2];
#pragma unroll
                for (int m = 0; m < 4; ++m)
#pragma unroll
                    for (int bj = 0; bj < 2; ++bj) bb[m][bj] = *(const GAS u32x4*)(O + (size_t)(row0 + ai * 128 + m * 16) * 1024 + col0 + bj * 128);
#pragma unroll
                for (int m = 0; m < 4; ++m) {
                    const int row = row0 + ai * 128 + m * 16;
                    float ss = 0.f;
#pragma unroll
                    for (int bj = 0; bj < 2; ++bj) {
                        const size_t off = (size_t)row * 1024 + col0 + bj * 128;
                        const u32x4 b = bb[m][bj];
                        const f32x4 x0 = (f32x4){bflo(b.x), bfhi(b.x), bflo(b.y), bfhi(b.y)} + acc[ai][bj][m][0];
                        const f32x4 x1 = (f32x4){bflo(b.z), bfhi(b.z), bflo(b.w), bfhi(b.w)} + acc[ai][bj][m][1];
                        u32x4 w; w.x = pk2(x0[0], x0[1]); w.y = pk2(x0[2], x0[3]); w.z = pk2(x1[0], x1[1]); w.w = pk2(x1[2], x1[3]);
                        *(GAS u32x4*)(O + off) = w;
                        ss += (x0[0] * x0[0] + x0[1] * x0[1]) + (x0[2] * x0[2] + x0[3] * x0[3]) + (x1[0] * x1[0] + x1[1] * x1[1]) + (x1[2] * x1[2] + x1[3] * x1[3]);
                    }
                    ss += __shfl_xor(ss, 16); ss += __shfl_xor(ss, 32);
                    if (fq == 0) *(GAS float*)(ssq_out + (size_t)row * 16 + u.pn * 4 + wc) = ss;
                }
                asm volatile("" ::: "memory");
            }
        }
    }
};

struct Args { const float* in[17]; float* out; unsigned char* ws; int ph_lo, ph_hi; };

__device__ __forceinline__ void transpose_item(const float* __restrict__ W, int ldw, int nvalid, const float* __restrict__ gain, float qscale, int nq,
                                               bf16* __restrict__ WT, int ldt, int k0, int n0, LAS float* scr, int lane) {
    const int cq = 4 * (lane & 7), nc = n0 + cq;
    f32x4 v[8];
#pragma unroll
    for (int j = 0; j < 8; ++j) {
        const float* src = W + (size_t)(k0 + 8 * j + (lane >> 3)) * ldw + nc;
        if (nc + 3 < nvalid) v[j] = __builtin_nontemporal_load((const GAS f32x4*)src);
        else { v[j] = (f32x4){0.f, 0.f, 0.f, 0.f};
#pragma unroll
            for (int e = 0; e < 4; ++e) if (nc + e < nvalid) v[j][e] = *(const GAS float*)(src + e); }
    }
#pragma unroll
    for (int j = 0; j < 8; ++j) {
        const int kk = 8 * j + (lane >> 3);
        const float gsc = gain ? *(const GAS float*)(gain + k0 + kk) : 1.0f;
#pragma unroll
        for (int e = 0; e < 4; ++e) scr[kk * 33 + cq + e] = v[j][e] * gsc * ((nc + e < nq) ? qscale : 1.0f);
    }
    asm volatile("s_waitcnt lgkmcnt(0)" ::: "memory");
    const int c = lane & 7;
#pragma unroll
    for (int j = 0; j < 4; ++j) {
        const int nn = (lane >> 3) + 8 * j; const LAS float* s = scr + (8 * c) * 33 + nn;
        u32x4 o; o.x = pk2(s[0 * 33], s[1 * 33]); o.y = pk2(s[2 * 33], s[3 * 33]); o.z = pk2(s[4 * 33], s[5 * 33]); o.w = pk2(s[6 * 33], s[7 * 33]);
        *(u32x4*)(WT + (size_t)(n0 + nn) * ldt + k0 + 8 * c) = o;
    }
    asm volatile("s_waitcnt lgkmcnt(0)" ::: "memory");
}

__device__ __forceinline__ float wave_sum(float v) {
#pragma unroll
    for (int o = 1; o < 64; o <<= 1) v += __shfl_xor(v, o);
    return v;
}

__device__ __forceinline__ void prologue(const Args& a, LAS unsigned char* lds) {
    const int tid = otid(), lane = tid & 63, wave = __builtin_amdgcn_readfirstlane(tid >> 6);
    const int gw = blockIdx.x * 8 + wave, NGW = gridDim.x * 8;
    const int gt = blockIdx.x * 512 + tid, NGT = gridDim.x * 512;
    unsigned char* ws = optr(a.ws);
    LAS float* scr = (LAS float*)(lds + wave * 16384);
    const float* norm_mix = a.in[1]; const float* norm_ffn = a.in[2];
    constexpr int I0 = 2048, I1 = 512, I2 = 3072, I3 = 1024, I4 = 8192, I5 = 8192;
    for (int it = gw; it < I0 + I1 + I2 + I3 + I4 + I5; it += NGW) {
        int r = it;
        if (r < I0) { const int e = r >> 10, q = r & 1023, kb = q >> 6, nb = q & 63;
            transpose_item(a.in[4] + (size_t)e * 1024 * 2048, 2048, 2048, norm_mix + (2 * e) * 1024, QK_C2, 512, (bf16*)(ws + WS_WAB_IN) + (size_t)e * 2048 * 1024, 1024, kb * 64, nb * 32, scr, lane); continue; }
        r -= I0;
        if (r < I1) { const int e = r >> 8, q = r & 255, kb = q >> 5, nb = q & 31;
            transpose_item(a.in[9] + (size_t)e * 1024 * 1024, 1024, 1024, nullptr, 1.f, 0, (bf16*)(ws + WS_WAB_OUT) + (size_t)e * 1024 * 1024, 1024, kb * 64, nb * 32, scr, lane); continue; }
        r -= I1;
        if (r < I2) { const int o = r / 1536, q = r % 1536, kb = q / 96, nb = q % 96;
            transpose_item(a.in[10] + (size_t)o * 1024 * GLA_N, GLA_N, GLA_N, norm_mix + (2 * o + 1) * 1024, 1.f, 0, (bf16*)(ws + WS_WGLA_IN) + (size_t)o * GLA_NP * 1024, 1024, kb * 64, nb * 32, scr, lane); continue; }
        r -= I2;
        if (r < I3) { const int o = r >> 9, q = r & 511, kb = q >> 5, nb = q & 31;
            transpose_item(a.in[14] + (size_t)o * 1024 * 1024, 1024, 1024, nullptr, 1.f, 0, (bf16*)(ws + WS_WGLA_OUT) + (size_t)o * 1024 * 1024, 1024, kb * 64, nb * 32, scr, lane); continue; }
        r -= I3;
        if (r < I4) { const int l = r >> 11, q = r & 2047, kb = q >> 7, nb = q & 127;
            transpose_item(a.in[15] + (size_t)l * 1024 * 4096, 4096, 4096, norm_ffn + l * 1024, 1.f, 0, (bf16*)(ws + WS_W1) + (size_t)l * 4096 * 1024, 1024, kb * 64, nb * 32, scr, lane); continue; }
        r -= I4;
        { const int l = r >> 11, q = r & 2047, kb = q >> 5, nb = q & 31;
            transpose_item(a.in[16] + (size_t)l * 4096 * 1024, 1024, 1024, nullptr, 1.f, 0, (bf16*)(ws + WS_W2) + (size_t)l * 1024 * 4096, 4096, kb * 64, nb * 32, scr, lane); }
    }
    for (int i = gt; i < 131072; i += NGT) {
        const int iw = __builtin_amdgcn_readfirstlane(i >> 7);
        const int o = iw >> 9, n = iw & 511, k0 = (i & 127) * 8;
        const float* wup = a.in[11] + (size_t)o * 16 * 512 + n;
        const float* win = a.in[10] + (size_t)o * 1024 * GLA_N + (size_t)k0 * GLA_N + 3072;
        const float* gn = norm_mix + (2 * o + 1) * 1024 + k0;
        float acc[8];
#pragma unroll
        for (int j = 0; j < 8; ++j) {
            float sacc = 0.f;
#pragma unroll
            for (int r4 = 0; r4 < 4; ++r4) { const f32x4 w = *(const GAS f32x4*)(win + (size_t)j * GLA_N + 4 * r4);
                sacc += w[0] * wup[(4 * r4) * 512] + w[1] * wup[(4 * r4 + 1) * 512] + w[2] * wup[(4 * r4 + 2) * 512] + w[3] * wup[(4 * r4 + 3) * 512]; }
            acc[j] = sacc * gn[j];
        }
        u32x4 ov; ov.x = pk2(acc[0], acc[1]); ov.y = pk2(acc[2], acc[3]); ov.z = pk2(acc[4], acc[5]); ov.w = pk2(acc[6], acc[7]);
        *(u32x4*)((bf16*)(ws + WS_WGLA_IN) + (size_t)o * GLA_NP * 1024 + (size_t)(3072 + n) * 1024 + k0) = ov;
    }
    for (int i = gt; i < 131072; i += NGT) {
        const int iw = __builtin_amdgcn_readfirstlane(i >> 10);
        const int e = iw >> 6, g = (iw >> 4) & 3, c8 = iw & 15, n = i & 1023;
        const float* pw = a.in[7] + ((size_t)(e * 4 + g) * 128 + c8 * 8) * 128;
        const float* sc = a.in[8] + e * 512 + g * 128;
        const float* wo = a.in[9] + (size_t)e * 1024 * 1024 + (size_t)(512 + g * 128) * 1024 + n;
        float acc[8] = {0.f, 0.f, 0.f, 0.f, 0.f, 0.f, 0.f, 0.f};
        for (int d0 = 0; d0 < 128; d0 += 16) {
            float w[16];
#pragma unroll
            for (int dd = 0; dd < 16; ++dd) w[dd] = *(const GAS float*)(wo + (size_t)(d0 + dd) * 1024);
#pragma unroll
            for (int dd = 0; dd < 16; ++dd) { const float ws_ = w[dd] * sc[d0 + dd];
#pragma unroll
                for (int j = 0; j < 8; ++j) acc[j] += pw[j * 128 + d0 + dd] * ws_; }
        }
        u32x4 o; o.x = pk2(acc[0], acc[1]); o.y = pk2(acc[2], acc[3]); o.z = pk2(acc[4], acc[5]); o.w = pk2(acc[6], acc[7]);
        *(u32x4*)((bf16*)(ws + WS_WAB_OUT) + (size_t)e * 1024 * 1024 + (size_t)n * 1024 + 512 + g * 128 + c8 * 8) = o;
    }
    float* ssq = (float*)(ws + WS_SSQ);
    for (int m = gw * 2; m < T_TOK; m += NGW * 2) {
        f32x4 v[2][4];
#pragma unroll
        for (int rr = 0; rr < 2; ++rr)
#pragma unroll
            for (int j = 0; j < 4; ++j) v[rr][j] = __builtin_nontemporal_load((const GAS f32x4*)(a.in[0] + (size_t)(m + rr) * 1024) + lane + 64 * j);
#pragma unroll
        for (int rr = 0; rr < 2; ++rr) {
            float s = 0.f;
            unsigned long long* o8 = (unsigned long long*)((bf16*)(ws + WS_XB) + (size_t)(m + rr) * 1024) + lane;
#pragma unroll
            for (int j = 0; j < 4; ++j) { const f32x4 q = v[rr][j]; s += (q.x * q.x + q.y * q.y) + (q.z * q.z + q.w * q.w);
                o8[64 * j] = (unsigned long long)pk2(q.x, q.y) | ((unsigned long long)pk2(q.z, q.w) << 32); }
            s = wave_sum(s);
            if (lane < 16) ssq[(size_t)(m + rr) * 16 + lane] = (lane == 0) ? s : 0.f;
        }
    }
}

__device__ __forceinline__ void final_norm(const Args& a) {
    const int tid = otid(), lane = tid & 63, wave = tid >> 6;
    const int gw = blockIdx.x * 8 + wave, NGW = gridDim.x * 8;
    const f32x4* gn = (const f32x4*)optr(a.in[3]);
    float* outp = optr(a.out);
    const bf16* xb = (const bf16*)(optr(a.ws) + WS_XB);
    for (int m = gw; m < T_TOK; m += NGW) {
        const u32x4 r0 = gld((const u32x4*)(xb + (size_t)m * 1024 + lane * 16)), r1 = gld((const u32x4*)(xb + (size_t)m * 1024 + lane * 16 + 8));
        float v[16] = {bflo(r0.x), bfhi(r0.x), bflo(r0.y), bfhi(r0.y), bflo(r0.z), bfhi(r0.z), bflo(r0.w), bfhi(r0.w),
                       bflo(r1.x), bfhi(r1.x), bflo(r1.y), bfhi(r1.y), bflo(r1.z), bfhi(r1.z), bflo(r1.w), bfhi(r1.w)};
        float s = 0.f;
#pragma unroll
        for (int j = 0; j < 16; ++j) s += v[j] * v[j];
        const float rs = rsqrtf(wave_sum(s) * (1.0f / 1024.0f) + RMS_EPS);
        f32x4* op = (f32x4*)(outp + (size_t)m * 1024 + lane * 16);
#pragma unroll
        for (int j = 0; j < 4; ++j) { const f32x4 g = gld(gn + lane * 4 + j); gst(op + j, (f32x4){v[4 * j] * rs * g[0], v[4 * j + 1] * rs * g[1], v[4 * j + 2] * rs * g[2], v[4 * j + 3] * rs * g[3]}); }
    }
}

template <int W> __device__ __forceinline__ void pool_item(const bf16* __restrict__ PROJ, bf16* __restrict__ CAT, int tb, int c8) {
    const int t0 = tb * 16; const bool first = ((t0 & (SEQ - 1)) == 0);
    const bf16* up = PROJ + (size_t)t0 * AB_N + 1536 + c8 * 8;
    u32x4 rows[15 + W];
#pragma unroll
    for (int k = 0; k < 15 + W; ++k) {
        const int dt = k - (W - 1);
        rows[k] = (dt < 0 && first) ? (u32x4){0u, 0u, 0u, 0u} : gld((const u32x4*)(up + (ptrdiff_t)dt * AB_N));
    }
    float rs[8] = {0.f, 0.f, 0.f, 0.f, 0.f, 0.f, 0.f, 0.f};
#pragma unroll
    for (int k = 0; k < W; ++k) { const u32x4 v = rows[k];
        rs[0] += bflo(v.x); rs[1] += bfhi(v.x); rs[2] += bflo(v.y); rs[3] += bfhi(v.y); rs[4] += bflo(v.z); rs[5] += bfhi(v.z); rs[6] += bflo(v.w); rs[7] += bfhi(v.w); }
#pragma unroll
    for (int i = 0; i < 16; ++i) {
        const u32x4 v = rows[W - 1 + i];
        const float u0[8] = {bflo(v.x), bfhi(v.x), bflo(v.y), bfhi(v.y), bflo(v.z), bfhi(v.z), bflo(v.w), bfhi(v.w)};
        const int cnt = first ? ((i + 1 < W) ? i + 1 : W) : W;
        const float inv = 1.0f / (float)cnt;
        u32x4 o; o.x = pk2(rs[0] * inv - u0[0], rs[1] * inv - u0[1]); o.y = pk2(rs[2] * inv - u0[2], rs[3] * inv - u0[3]);
        o.z = pk2(rs[4] * inv - u0[4], rs[5] * inv - u0[5]); o.w = pk2(rs[6] * inv - u0[6], rs[7] * inv - u0[7]);
        gst((u32x4*)(CAT + (size_t)(t0 + i) * 1024 + 512 + c8 * 8), o);
        if (i < 15) { const u32x4 a = rows[W + i], d = rows[i];
            rs[0] += bflo(a.x) - bflo(d.x); rs[1] += bfhi(a.x) - bfhi(d.x); rs[2] += bflo(a.y) - bflo(d.y); rs[3] += bfhi(a.y) - bfhi(d.y);
            rs[4] += bflo(a.z) - bflo(d.z); rs[5] += bfhi(a.z) - bfhi(d.z); rs[6] += bflo(a.w) - bflo(d.w); rs[7] += bfhi(a.w) - bfhi(d.w); }
    }
}
__device__ __forceinline__ void pool_phase(const bf16* __restrict__ PROJ, bf16* __restrict__ CAT) {
    const int gt = blockIdx.x * 512 + otid(), NGT = gridDim.x * 512;
    for (int i = gt; i < (T_TOK / 16) * 64; i += NGT) {
        const int tb = i >> 6, c8 = i & 63, g = c8 >> 4;
        if (g == 0) pool_item<2>(PROJ, CAT, tb, c8); else if (g == 1) pool_item<4>(PROJ, CAT, tb, c8); else if (g == 2) pool_item<8>(PROJ, CAT, tb, c8); else pool_item<16>(PROJ, CAT, tb, c8);
    }
}

constexpr int AT_KP = 144, AT_VP = 320, AT_KBUF = 64 * AT_KP, AT_VBUF = 64 * AT_VP, AT_QOFF = 2 * AT_KBUF + 2 * AT_VBUF;
#ifndef AT_SB1
#define AT_SB1
#endif
#ifndef AT_SB2
#define AT_SB2 __builtin_amdgcn_sched_barrier(0)
#endif
__device__ __forceinline__ void attn_unit(LAS unsigned char* lds, const bf16* __restrict__ PROJ, bf16* __restrict__ CAT, f32x4* stash,
                                          int b, int h, int qb, float lam, const float* __restrict__ subln, float oscale) {
    const int tid = otid(), lane = tid & 63, wid = __builtin_amdgcn_readfirstlane(tid >> 6), r32 = lane & 31, hi = lane >> 5;
    const size_t rowbase = (size_t)b * SEQ;
    const int NT = 4 * qb + 4, my_nt = 4 * qb + (wid >> 1) + 1;
    const size_t myrow = rowbase + (size_t)qb * 256 + wid * 32 + r32;
    const bf16* qrow = PROJ + myrow * AB_N + h * 128;
    const int krow = tid >> 3, kch = tid & 7, vrow = tid >> 4, vch = tid & 15;
    LAS unsigned char* kdst = lds + krow * AT_KP + kch * 16;
    LAS unsigned char* vdst = lds + 2 * AT_KBUF + vrow * AT_VP + vch * 16;
    const LAS unsigned char* kfb = lds + r32 * AT_KP + hi * 16;
    const LAS unsigned char* vfb = lds + 2 * AT_KBUF + (4 * hi + ((lane >> 2) & 3)) * AT_VP + (16 * ((lane >> 4) & 1) + 4 * (lane & 3)) * 2;
    f32x16 O[4];
#pragma nounroll
    for (int s = 0; s < 2; ++s) {
        bf16x8 qf[4];
#pragma unroll
        for (int ks = 0; ks < 4; ++ks) qf[ks] = gld((const bf16x8*)(qrow + s * 64 + ks * 16 + hi * 8));
        const bf16* kg = PROJ + (rowbase + krow) * AB_N + 512 + h * 128 + s * 64 + kch * 8;
        const bf16* vg = PROJ + (rowbase + vrow) * AB_N + 1024 + h * 128 + vch * 8;
        u32x4 kr = gld((const u32x4*)kg), vr0 = gld((const u32x4*)vg), vr1 = gld((const u32x4*)(vg + (size_t)32 * AB_N));
        *(LAS u32x4*)kdst = kr; *(LAS u32x4*)vdst = vr0; *(LAS u32x4*)(vdst + 32 * AT_VP) = vr1;
        { const size_t go = (size_t)64 * AB_N; kr = gld((const u32x4*)(kg + go)); vr0 = gld((const u32x4*)(vg + go)); vr1 = gld((const u32x4*)(vg + go + (size_t)32 * AB_N)); }
        __syncthreads();
        float m = 0.f, l = 0.f;
        f32x16 negm16;
#pragma unroll
        for (int r = 0; r < 16; ++r) negm16[r] = 0.f;
#pragma unroll
        for (int nb = 0; nb < 4; ++nb)
#pragma unroll
            for (int r = 0; r < 16; ++r) O[nb][r] = 0.f;
        for (int t = 0; t < NT; ++t) {
            const int cur = t & 1;
            const bool more = (t + 1 < NT), act = (t < my_nt);
            if (more) {
                const int nx = cur ^ 1;
                *(LAS u32x4*)(kdst + nx * AT_KBUF) = kr; *(LAS u32x4*)(vdst + nx * AT_VBUF) = vr0; *(LAS u32x4*)(vdst + nx * AT_VBUF + 32 * AT_VP) = vr1;
            }
            if (t + 2 < NT) {
                const size_t go = (size_t)(t + 2) * 64 * AB_N;
                kr = gld((const u32x4*)(kg + go)); vr0 = gld((const u32x4*)(vg + go)); vr1 = gld((const u32x4*)(vg + go + (size_t)32 * AB_N));
            }
            bf16x8 pf[4];
            if (act) {
                f32x16 p0, p1;
                const LAS unsigned char* kb = kfb + cur * AT_KBUF;
                p0 = MFMA32(*(const LAS bf16x8*)(kb), qf[0], negm16);
                p1 = MFMA32(*(const LAS bf16x8*)(kb + 32 * AT_KP), qf[0], negm16);
#pragma unroll
                for (int ks = 1; ks < 4; ++ks) {
                    p0 = MFMA32(*(const LAS bf16x8*)(kb + ks * 32), qf[ks], p0);
                    p1 = MFMA32(*(const LAS bf16x8*)(kb + 32 * AT_KP + ks * 32), qf[ks], p1);
                }
                if (t == 0) {
                    float mx = fmaxf(p0[0], p1[0]);
#pragma unroll
                    for (int r = 1; r < 16; ++r) mx = fmaxf(mx, fmaxf(p0[r], p1[r]));
                    mx = fmaxf(mx, __shfl_xor(mx, 32));
                    m = mx;
#pragma unroll
                    for (int r = 0; r < 16; ++r) negm16[r] = -mx;
#pragma unroll
                    for (int r = 0; r < 16; ++r) { p0[r] -= mx; p1[r] -= mx; }
                }
                float ls = 0.f;
#pragma unroll
                for (int r = 0; r < 16; ++r) { p0[r] = __builtin_amdgcn_exp2f(p0[r]); p1[r] = __builtin_amdgcn_exp2f(p1[r]); ls += p0[r] + p1[r]; }
                if (__builtin_amdgcn_ballot_w64(!(ls < 1073741824.0f)) != 0ull) {
                    const float lsr = ls + __shfl_xor(ls, 32);
                    float d = floorf(__log2f(fminf(lsr, 3.0e38f))); d = fmaxf(d, 0.f);
                    const float alpha = __builtin_amdgcn_exp2f(-d);
                    m += d; l *= alpha; ls *= alpha;
#pragma unroll
                    for (int r = 0; r < 16; ++r) negm16[r] = -m;
#pragma unroll
                    for (int r = 0; r < 16; ++r) { p0[r] *= alpha; p1[r] *= alpha; }
#pragma unroll
                    for (int nb = 0; nb < 4; ++nb)
#pragma unroll
                        for (int r = 0; r < 16; ++r) O[nb][r] *= alpha;
                }
                l += ls;
                pf[0] = pack8(p0[0], p0[1], p0[2], p0[3], p0[4], p0[5], p0[6], p0[7]);
                pf[1] = pack8(p0[8], p0[9], p0[10], p0[11], p0[12], p0[13], p0[14], p0[15]);
                pf[2] = pack8(p1[0], p1[1], p1[2], p1[3], p1[4], p1[5], p1[6], p1[7]);
                pf[3] = pack8(p1[8], p1[9], p1[10], p1[11], p1[12], p1[13], p1[14], p1[15]);
            }
            if (act) {
                const LAS unsigned char* vb = vfb + cur * AT_VBUF;
                v4i16_t vlo[2][4], vhi[2][4];
#pragma unroll
                for (int nb = 0; nb < 4; ++nb) { vlo[0][nb] = trrd(vb + nb * 64); vhi[0][nb] = trrd(vb + 8 * AT_VP + nb * 64); }
                __builtin_amdgcn_sched_barrier(0);
#pragma unroll
                for (int kk = 0; kk < 4; ++kk) {
                    if (kk < 3) {
#pragma unroll
                        for (int nb = 0; nb < 4; ++nb) { vlo[(kk + 1) & 1][nb] = trrd(vb + 16 * (kk + 1) * AT_VP + nb * 64); vhi[(kk + 1) & 1][nb] = trrd(vb + 16 * (kk + 1) * AT_VP + 8 * AT_VP + nb * 64); }
                    }
#pragma unroll
                    for (int nb = 0; nb < 4; ++nb) O[nb] = MFMA32(cat44(vlo[kk & 1][nb], vhi[kk & 1][nb]), pf[kk], O[nb]);
                    __builtin_amdgcn_sched_barrier(0);
                }
            }
            __syncthreads();
        }
        const float lt = l + __shfl_xor(l, 32);
        const float inv = 1.0f / lt;
#pragma unroll
        for (int nb = 0; nb < 4; ++nb)
#pragma unroll
            for (int r = 0; r < 16; ++r) O[nb][r] *= inv;
        f32x4* sp = stash + tid * 16;
        if (s == 0) {
#pragma unroll
            for (int nb = 0; nb < 4; ++nb)
#pragma unroll
                for (int q = 0; q < 4; ++q) gst(sp + nb * 4 + q, (f32x4){O[nb][4 * q], O[nb][4 * q + 1], O[nb][4 * q + 2], O[nb][4 * q + 3]});
        } else {
            float ss = 0.f, lamv = lam;
#pragma unroll
            for (int nb = 0; nb < 4; ++nb)
#pragma unroll
                for (int q = 0; q < 4; ++q) {
                    const f32x4 o1 = gld(sp + nb * 4 + q);
#pragma unroll
                    for (int i = 0; i < 4; ++i) { const float d = o1[i] - lamv * O[nb][4 * q + i]; O[nb][4 * q + i] = d; ss += d * d; }
                    asm volatile("" : "+v"(lamv), "+v"(O[nb][4 * q]), "+v"(O[nb][4 * q + 1]), "+v"(O[nb][4 * q + 2]), "+v"(O[nb][4 * q + 3]) :: "memory");
                }
            ss += __shfl_xor(ss, 32);
            float rs = rsqrtf(ss * (1.0f / 128.0f) + RMS_EPS) * oscale;
            bf16* orow = CAT + myrow * 1024 + h * 128;
#pragma unroll
            for (int nb = 0; nb < 4; ++nb)
#pragma unroll
                for (int q = 0; q < 4; ++q) {
                    const int dv = 32 * nb + 8 * q + 4 * hi;
                    const f32x4 gsub = gld((const f32x4*)(subln + dv));
                    u32x2 w; w.x = pk2(O[nb][4 * q] * rs * gsub[0], O[nb][4 * q + 1] * rs * gsub[1]); w.y = pk2(O[nb][4 * q + 2] * rs * gsub[2], O[nb][4 * q + 3] * rs * gsub[3]);
                    asm volatile("" : "+v"(rs), "+v"(w.x), "+v"(w.y));
                    gst((u32x2*)(orow + dv), w);
                }
        }
    }
}

__device__ __forceinline__ void attn_phase(const Args& a, LAS unsigned char* lds, int layer) {
    const int e = layer >> 1;
    unsigned char* wsl = optr(a.ws);
    const bf16* PROJ = (const bf16*)(wsl + WS_R); bf16* CAT = (bf16*)(wsl + WS_CAT);
    pool_phase(PROJ, CAT);
    const float* lp = a.in[5] + e * 256;
    float d1 = 0.f, d2 = 0.f;
    for (int i = 0; i < 64; ++i) { d1 += lp[i] * lp[64 + i]; d2 += lp[128 + i] * lp[192 + i]; }
    const float lam_init = 0.8f - 0.6f * expf(-0.3f * (float)layer);
    const float lam = expf(d1) - expf(d2) + lam_init;
    const float* subln = a.in[6] + e * 128;
    f32x4* stash_base = (f32x4*)(wsl + WS_STASH);
    int ord = 0;
    for (int pi = blockIdx.x; pi < 256; pi += gridDim.x, ++ord) {
        const int xcd = pi & 7, loc = pi >> 3, bh = xcd * 2 + (loc >> 4), j = loc & 15;
        const int b = bh >> 2, h = bh & 3;
        f32x4* st = stash_base + ((size_t)pi * 2) * 8192;
#pragma nounroll
        for (int u2 = 0; u2 < 2; ++u2) attn_unit(lds, PROJ, CAT, st + u2 * 8192, b, h, u2 ? j : 31 - j, lam, subln, 1.0f - lam_init);
    }
}

constexpr int GL_GKL = 0, GL_TOT = 4096, GL_SSQ = 6144, GL_V = 8192, GL_VP = 576, GL_A = GL_V + 64 * GL_VP  ;
constexpr int GL_KHP = 144, GL_QP = 272, GL_KT = GL_A + 64 * GL_QP, GL_QR = GL_KT + 64 * GL_QP  , GL_KR = GL_QR + 16384  ;
static_assert(GL_KR + 16384 <= 131072, "GLA LDS map");

__device__ __forceinline__ void gla_stage(LAS unsigned char* lds, const bf16* __restrict__ PROJ, size_t tok0, int h, int tid, bool with_q) {
#pragma unroll
    for (int i = 0; i < 2; ++i) {
        const int c = tid + 512 * i, row = c >> 4, ch = c & 15;
        *(LAS u32x4*)(lds + GL_KR + row * 256 + ch * 16) = gld((const u32x4*)(PROJ + (tok0 + row) * GLA_NP + 512 + h * 128 + ch * 8));
        if (with_q) *(LAS u32x4*)(lds + GL_QR + row * 256 + ch * 16) = gld((const u32x4*)(PROJ + (tok0 + row) * GLA_NP + h * 128 + ch * 8));
    }
#pragma unroll
    for (int i = 0; i < 2; ++i) {
        const int c = tid + 512 * i, row = c >> 4, ch = c & 15;
        *(LAS u32x4*)(lds + GL_A + row * 256 + ch * 16) = gld((const u32x4*)(PROJ + (tok0 + row) * GLA_NP + 3072 + h * 128 + ch * 8));
    }
#pragma unroll
    for (int i = 0; i < 4; ++i) {
        const int c = tid + 512 * i, row = c >> 5, ch = c & 31;
        const u32x4 v = *(const u32x4*)(PROJ + (tok0 + row) * GLA_NP + 1024 + h * 256 + ch * 8);
        *(LAS u32x4*)(lds + GL_V + row * GL_VP + ch * 16) = v;
    }
}
__device__ __forceinline__ void gla_gate(LAS unsigned char* lds, const float* __restrict__ bgk, int h, int kd, int part, float (&bpre)[16], float& blast) {
    const LAS unsigned short* gk = (const LAS unsigned short*)(lds + GL_A) + (16 * part) * 128 + kd;
    LAS float* tot = (LAS float*)(lds + GL_TOT);
    const float bias = bgk[h * 128 + kd];
    float run = 0.f;
#pragma unroll
    for (int i = 0; i < 16; ++i) {
        const float x = bf2f(gk[i * 128]) + bias;
        const float ls = fminf(x, 0.f) - __logf(1.0f + __expf(-fabsf(x)));
        run += ls * (1.0f / 16.0f); bpre[i] = run;
    }
    tot[part * 128 + kd] = run;
    __syncthreads();
    float off = 0.f, all = 0.f;
#pragma unroll
    for (int p = 0; p < 4; ++p) { const float v = tot[p * 128 + kd]; all += v; if (p < part) off += v; }
#pragma unroll
    for (int i = 0; i < 16; ++i) bpre[i] += off;
    blast = all;
}
__device__ __forceinline__ bf16* gla_ubase(unsigned char* ob, int unit) {
    return (bf16*)ob + (size_t)unit * 32768;
}

__device__ __forceinline__ void gla_g1(const Args& a, LAS unsigned char* lds, int o) {
    const int tid = otid(), lane = tid & 63, wid = __builtin_amdgcn_readfirstlane(tid >> 6), r32 = lane & 31, hi = lane >> 5;
    const int kd = tid & 127, part = tid >> 7;
    unsigned char* wsl = optr(a.ws); unsigned char* outl = (unsigned char*)optr(a.out);
    const bf16* PROJ = (const bf16*)(wsl + WS_R);
    const float* bgk = a.in[12] + o * 512;
    float* DEC = (float*)(wsl + WS_DEC);
    for (int unit = blockIdx.x; unit < 2048; unit += gridDim.x) {
        const int c = unit & 127, h = (unit >> 7) & 3, b = unit >> 9;
        const size_t tok0 = (size_t)b * SEQ + (size_t)c * 64;
        gla_stage(lds, PROJ, tok0, h, tid, false);
        __syncthreads();
        float bpre[16], blast;
        gla_gate(lds, bgk, h, kd, part, bpre, blast);
        {
            const LAS unsigned short* kp = (const LAS unsigned short*)(lds + GL_KR + (16 * part) * 256) + kd;
            float kv[16];
#pragma unroll
            for (int i = 0; i < 16; ++i) kv[i] = bf2f(kp[i * 128]) * __expf(blast - bpre[i]);
            u32x4 w0, w1;
            w0.x = pk2(kv[0], kv[1]); w0.y = pk2(kv[2], kv[3]); w0.z = pk2(kv[4], kv[5]); w0.w = pk2(kv[6], kv[7]);
            w1.x = pk2(kv[8], kv[9]); w1.y = pk2(kv[10], kv[11]); w1.z = pk2(kv[12], kv[13]); w1.w = pk2(kv[14], kv[15]);
            LAS unsigned char* dst = lds + GL_A + kd * GL_KHP + part * 32;
            *(LAS u32x4*)dst = w0; *(LAS u32x4*)(dst + 16) = w1;
            if (part == 0) DEC[(size_t)unit * 128 + kd] = __expf(blast);
        }
        __syncthreads();
        bf16* ub = gla_ubase(outl, unit);
        const LAS unsigned char* vbp = lds + GL_V + (8 * hi + ((lane >> 2) & 3)) * GL_VP + (32 * wid + 16 * ((lane >> 4) & 1) + 4 * (lane & 3)) * 2;
#pragma unroll
        for (int kb = 0; kb < 4; ++kb) {
            f32x16 acc;
#pragma unroll
            for (int r = 0; r < 16; ++r) acc[r] = 0.f;
#pragma unroll
            for (int s = 0; s < 4; ++s) {
                const bf16x8 af = *(const LAS bf16x8*)(lds + GL_A + (32 * kb + r32) * GL_KHP + (16 * s + 8 * hi) * 2);
                const v4i16_t lo = trrd(vbp + 16 * s * GL_VP), hh = trrd(vbp + 16 * s * GL_VP + 4 * GL_VP);
                acc = MFMA32(af, cat44(lo, hh), acc);
            }
            bf16* up = ub + ((size_t)((kb * 8 + wid) * 2) * 64 + lane) * 8;
            *(bf16x8*)up = pack8(acc[0], acc[1], acc[2], acc[3], acc[4], acc[5], acc[6], acc[7]);
            *(bf16x8*)(up + 512) = pack8(acc[8], acc[9], acc[10], acc[11], acc[12], acc[13], acc[14], acc[15]);
        }
        __syncthreads();
    }
}

__device__ __forceinline__ void gla_g2(const Args& a) {
    unsigned char* wsl = optr(a.ws); unsigned char* outl = (unsigned char*)optr(a.out);
    const float* DEC = (const float*)(wsl + WS_DEC);
    const int tid_g2 = otid();
    if (tid_g2 < 256)
    for (int gt = blockIdx.x * 256 + tid_g2; gt < 65536; gt += gridDim.x * 256) {
        const int bh = gt >> 12, vec = gt & 4095, ln = vec & 63, s2 = (vec >> 6) & 1, kb = vec >> 10, hi = ln >> 5;
        const int kdA = 32 * kb + 16 * s2 + 4 * hi;
        float S[8] = {0.f, 0.f, 0.f, 0.f, 0.f, 0.f, 0.f, 0.f};
        for (int c0 = 0; c0 < 128; c0 += 8) {
            u32x4 uv[8]; f32x4 da[8], db[8];
#pragma unroll
            for (int i = 0; i < 8; ++i) {
                const int unit = bh * 128 + c0 + i;
                uv[i] = *(const u32x4*)(gla_ubase(outl, unit) + (size_t)vec * 8);
                da[i] = *(const f32x4*)(DEC + (size_t)unit * 128 + kdA); db[i] = *(const f32x4*)(DEC + (size_t)unit * 128 + kdA + 8);
            }
#pragma unroll
            for (int i = 0; i < 8; ++i) {
                const int unit = bh * 128 + c0 + i;
                u32x4 o; o.x = pk2(S[0], S[1]); o.y = pk2(S[2], S[3]); o.z = pk2(S[4], S[5]); o.w = pk2(S[6], S[7]);
                *(u32x4*)(gla_ubase(outl, unit) + (size_t)vec * 8) = o;
                S[0] = S[0] * da[i][0] + bflo(uv[i].x); S[1] = S[1] * da[i][1] + bfhi(uv[i].x); S[2] = S[2] * da[i][2] + bflo(uv[i].y); S[3] = S[3] * da[i][3] + bfhi(uv[i].y);
                S[4] = S[4] * db[i][0] + bflo(uv[i].z); S[5] = S[5] * db[i][1] + bfhi(uv[i].z); S[6] = S[6] * db[i][2] + bflo(uv[i].w); S[7] = S[7] * db[i][3] + bfhi(uv[i].w);
            }
        }
    }
}

__device__ __forceinline__ void gla_g3(const Args& a, LAS unsigned char* lds, int o) {
    const int tid = otid(), lane = tid & 63, wid = __builtin_amdgcn_readfirstlane(tid >> 6), r32 = lane & 31, hi = lane >> 5;
    const int kd = tid & 127, part = tid >> 7;
    unsigned char* wsl = optr(a.ws); unsigned char* outl = (unsigned char*)optr(a.out);
    const bf16* PROJ = (const bf16*)(wsl + WS_R); bf16* GO = (bf16*)(wsl + WS_CAT);
    const float* bgk = a.in[12] + o * 512;
    const float* gnorm = a.in[13] + o * 1024;
    LAS float* ssq = (LAS float*)(lds + GL_SSQ);
    for (int unit = blockIdx.x; unit < 2048; unit += gridDim.x) {
        const int c = unit & 127, h = (unit >> 7) & 3, b = unit >> 9;
        const size_t tok0 = (size_t)b * SEQ + (size_t)c * 64;
        gla_stage(lds, PROJ, tok0, h, tid, true);
        bf16x8 sfr[4][2]; u32x2 gvr[2][4];
        {
            const bf16* sb0 = gla_ubase(outl, unit);
#pragma unroll
            for (int kb = 0; kb < 4; ++kb)
#pragma unroll
                for (int s2 = 0; s2 < 2; ++s2) sfr[kb][s2] = gld((const bf16x8*)(sb0 + ((size_t)((kb * 8 + wid) * 2 + s2) * 64 + lane) * 8));
#pragma unroll
            for (int ib = 0; ib < 2; ++ib)
#pragma unroll
                for (int q = 0; q < 4; ++q) gvr[ib][q] = gld((const u32x2*)(PROJ + (tok0 + 32 * ib + r32) * GLA_NP + 2048 + h * 256 + 32 * wid + 8 * q + 4 * hi));
        }
        __syncthreads();
        float bpre[16], blast;
        gla_gate(lds, bgk, h, kd, part, bpre, blast);
        {
            const LAS unsigned short* qp = (const LAS unsigned short*)(lds + GL_QR + (16 * part) * 256) + kd;
            const LAS unsigned short* kp = (const LAS unsigned short*)(lds + GL_KR + (16 * part) * 256) + kd;
#pragma unroll
            for (int i = 0; i < 16; ++i) {
                const float qv = bf2f(qp[i * 128]) * 0.08838834764831845f * __expf(bpre[i]);
                const float kv = bf2f(kp[i * 128]) * __expf(-bpre[i]);
                const unsigned pqk = pk2(qv, kv);
                *(LAS unsigned short*)(lds + GL_A + (16 * part + i) * GL_QP + kd * 2) = (unsigned short)(pqk & 0xffffu);
                *(LAS unsigned short*)(lds + GL_KT + (16 * part + i) * GL_QP + kd * 2) = (unsigned short)(pqk >> 16);
            }
        }
        __syncthreads();
        bf16x8 pf[3][2];
#pragma unroll
        for (int blk = 0; blk < 3; ++blk) {
            const int jb = (blk == 2) ? 1 : 0, ib = (blk >= 1) ? 1 : 0;
            f32x16 x;
#pragma unroll
            for (int r = 0; r < 16; ++r) x[r] = 0.f;
#pragma unroll
            for (int ks = 0; ks < 8; ++ks) {
                const bf16x8 af = *(const LAS bf16x8*)(lds + GL_KT + (32 * jb + r32) * GL_QP + (16 * ks + 8 * hi) * 2);
                const bf16x8 bq = *(const LAS bf16x8*)(lds + GL_A + (32 * ib + r32) * GL_QP + (16 * ks + 8 * hi) * 2);
                x = MFMA32(af, bq, x);
            }
            if (jb == ib) {
#pragma unroll
                for (int r = 0; r < 16; ++r) if (crow(r, hi) > r32) x[r] = 0.f;
            }
            pf[blk][0] = pack8(x[0], x[1], x[2], x[3], x[4], x[5], x[6], x[7]);
            pf[blk][1] = pack8(x[8], x[9], x[10], x[11], x[12], x[13], x[14], x[15]);
        }
        f32x16 oa[2];
#pragma unroll
        for (int r = 0; r < 16; ++r) { oa[0][r] = 0.f; oa[1][r] = 0.f; }
        const bf16* sb = gla_ubase(outl, unit);
#pragma unroll
        for (int kb = 0; kb < 4; ++kb)
#pragma unroll
            for (int s2 = 0; s2 < 2; ++s2) {
                const bf16x8 sf = sfr[kb][s2];
#pragma unroll
                for (int ib = 0; ib < 2; ++ib) {
                    const LAS unsigned char* qa = lds + GL_A + (32 * ib + r32) * GL_QP + (32 * kb + 16 * s2 + 4 * hi) * 2;
                    const u32x2 lo = *(const LAS u32x2*)qa, hh = *(const LAS u32x2*)(qa + 16);
                    const u32x4 qq = {lo.x, lo.y, hh.x, hh.y};
                    oa[ib] = MFMA32(sf, __builtin_bit_cast(bf16x8, qq), oa[ib]);
                }
            }
        const LAS unsigned char* vbp = lds + GL_V + (4 * hi + ((lane >> 2) & 3)) * GL_VP + (32 * wid + 16 * ((lane >> 4) & 1) + 4 * (lane & 3)) * 2;
#pragma unroll
        for (int blk = 0; blk < 3; ++blk) {
            const int jb = (blk == 2) ? 1 : 0, ib = (blk >= 1) ? 1 : 0;
#pragma unroll
            for (int s2 = 0; s2 < 2; ++s2) {
                const v4i16_t lo = trrd(vbp + (32 * jb + 16 * s2) * GL_VP), hh = trrd(vbp + (32 * jb + 16 * s2 + 8) * GL_VP);
                oa[ib] = MFMA32(cat44(lo, hh), pf[blk][s2], oa[ib]);
            }
        }
        float ss0 = 0.f, ss1 = 0.f;
#pragma unroll
        for (int r = 0; r < 16; ++r) { ss0 += oa[0][r] * oa[0][r]; ss1 += oa[1][r] * oa[1][r]; }
        ss0 += __shfl_xor(ss0, 32); ss1 += __shfl_xor(ss1, 32);
        if (hi == 0) { ssq[wid * 64 + r32] = ss0; ssq[wid * 64 + 32 + r32] = ss1; }
        __syncthreads();
#pragma unroll
        for (int ib = 0; ib < 2; ++ib) {
            const int tok = 32 * ib + r32; float tsum = 0.f;
#pragma unroll
            for (int w = 0; w < 8; ++w) tsum += ssq[w * 64 + tok];
            const float rs = rsqrtf(tsum * (1.0f / 256.0f) + RMS_EPS);
            const bf16* gp = PROJ + (tok0 + tok) * GLA_NP + 2048 + h * 256;
            bf16* op = GO + (tok0 + tok) * 1024 + h * 256;
#pragma unroll
            for (int q = 0; q < 4; ++q) {
                const int v0 = 32 * wid + 8 * q + 4 * hi;
                const u32x2 gv = gvr[ib][q];
                const f32x4 gn = *(const f32x4*)(gnorm + h * 256 + v0);
                const float g0 = bflo(gv.x), g1 = bfhi(gv.x), g2 = bflo(gv.y), g3 = bfhi(gv.y);
                const float o0 = oa[ib][4 * q] * rs * gn[0] * (g0 / (1.0f + __expf(-g0)));
                const float o1 = oa[ib][4 * q + 1] * rs * gn[1] * (g1 / (1.0f + __expf(-g1)));
                const float o2 = oa[ib][4 * q + 2] * rs * gn[2] * (g2 / (1.0f + __expf(-g2)));
                const float o3 = oa[ib][4 * q + 3] * rs * gn[3] * (g3 / (1.0f + __expf(-g3)));
                u32x2 w; w.x = pk2(o0, o1); w.y = pk2(o2, o3);
                *(u32x2*)(op + v0) = w;
            }
        }
        __syncthreads();
    }
}

#define XB_TMO      128
#define XB_XCNT(j)  (256  + 64 * (j))
#define XB_XSUB(j)  (1280 + 64 * (j))
#define XB_XGEN(j)  (2304 + 64 * (j))
#define XB_TOP      3328
#define XB_TOPGEN   3392
#define XCD_BAR_WORDS 3456
#define XB_SPIN_CAP (1u << 18)

__device__ __forceinline__ unsigned xb_ld(unsigned* p)              { return __hip_atomic_load(p, __ATOMIC_RELAXED, __HIP_MEMORY_SCOPE_AGENT); }
__device__ __forceinline__ unsigned xb_add(unsigned* p, unsigned v) { return __hip_atomic_fetch_add(p, v, __ATOMIC_RELAXED, __HIP_MEMORY_SCOPE_AGENT); }
__device__ __forceinline__ unsigned xb_xcc_id() { return (unsigned)__builtin_amdgcn_s_getreg((3 << 11) | 20) & 0xFu; }
#define XB_SPIN(cond, bar) do { unsigned _sp = 0; while (cond) { __builtin_amdgcn_s_sleep(1); \
    if ((++_sp & 255u) == 0u) { if (xb_ld(&(bar)[XB_TMO])) break; if (_sp > XB_SPIN_CAP) { atomicAdd(&(bar)[XB_TMO], 1u); break; } } } } while (0)

struct XcdBarrier {
    unsigned* bar; unsigned x;
    volatile LAS unsigned* st;
};

__device__ __forceinline__ XcdBarrier xcd_barrier_post(unsigned* bar, volatile LAS unsigned* st) {
    XcdBarrier b; b.bar = bar; b.x = xb_xcc_id(); b.st = st;
    if (threadIdx.x == 0) (void)xb_add(&bar[XB_XCNT(b.x)], 1u);
    return b;
}
__device__ __forceinline__ void xcd_barrier_complete(unsigned* bar, unsigned x, unsigned& nloc, unsigned& nx) {
    const unsigned G = gridDim.x * gridDim.y * gridDim.z;
    unsigned sum, cnt, mine, sp = 0u;
    for (;;) {
        sum = 0u; cnt = 0u; mine = 0u;
#pragma unroll
        for (unsigned j = 0; j < 16; ++j) { const unsigned c = xb_ld(&bar[XB_XCNT(j)]); sum += c; cnt += (c > 0u) ? 1u : 0u; mine = (j == x) ? c : mine; }
        if (sum == G) break;
        __builtin_amdgcn_s_sleep(1);
        if ((++sp & 255u) == 0u) { if (xb_ld(&bar[XB_TMO])) break; if (sp > XB_SPIN_CAP) { atomicAdd(&bar[XB_TMO], 1u); break; } }
    }
    nloc = mine > 0u ? mine : 1u; nx = cnt > 0u ? cnt : 1u;
}

__device__ __forceinline__ void xcd_barrier(const XcdBarrier& b) {
    asm volatile("s_waitcnt vmcnt(0)" ::: "memory");
    __syncthreads();
    if (threadIdx.x == 0) {
        unsigned* bar = b.bar;
        __builtin_amdgcn_s_waitcnt(0);
        unsigned nloc = b.st[0], nx = b.st[1];
        if (nloc == 0u) { xcd_barrier_complete(bar, b.x, nloc, nx); b.st[0] = nloc; b.st[1] = nx; }
        const unsigned old = xb_add(&bar[XB_XSUB(b.x)], 1u);
        const unsigned gen = old / nloc;
        if (old + 1u == (gen + 1u) * nloc) {
            __builtin_amdgcn_fence(__ATOMIC_RELEASE, "agent");
            asm volatile("s_waitcnt vmcnt(0)" ::: "memory");
            const unsigned og = xb_add(&bar[XB_TOP], 1u);
            const unsigned tg = og / nx;
            if (og + 1u == (tg + 1u) * nx) xb_add(&bar[XB_TOPGEN], 1u);
            else XB_SPIN(xb_ld(&bar[XB_TOPGEN]) == tg, bar);
            __builtin_amdgcn_fence(__ATOMIC_ACQUIRE, "agent");
            xb_add(&bar[XB_XGEN(b.x)], 1u);
            asm volatile("s_waitcnt vmcnt(0)" ::: "memory");
        } else {
            XB_SPIN(xb_ld(&bar[XB_XGEN(b.x)]) == gen, bar);
            __builtin_amdgcn_fence(__ATOMIC_ACQUIRE, "agent");
            asm volatile("s_waitcnt vmcnt(0)" ::: "memory");
        }
    }
    __syncthreads();
}

__global__ void __launch_bounds__(512, 2) mega_fwd(Args a) {
    extern __shared__ __attribute__((aligned(16))) unsigned char lds_raw[];
    LAS unsigned char* lds = (LAS unsigned char*)lds_raw;
    cg::grid_group grid = cg::this_grid();
    if (threadIdx.x < 2) *(volatile LAS unsigned*)(lds + LDS_BARST + 4 * threadIdx.x) = 0u;
    __syncthreads();
    if (a.ph_lo < 0) grid.sync();
    XcdBarrier bar = xcd_barrier_post((unsigned*)(a.ws + WS_CTL), (volatile LAS unsigned*)(lds + LDS_BARST));
    unsigned char* ws = a.ws;
    float* ssq = (float*)(ws + WS_SSQ);
    bf16* XB = (bf16*)(ws + WS_XB); bf16* CAT = (bf16*)(ws + WS_CAT); bf16* R = (bf16*)(ws + WS_R);
#ifndef EXTRA_SYNCS
#define EXTRA_SYNCS 0
#endif
    for (int es = 0; es < EXTRA_SYNCS; ++es) xcd_barrier(bar);
#ifndef REPEAT_MASK
#define REPEAT_MASK 0u
#endif
    for (int step = a.ph_lo; step < a.ph_hi; ++step)
    for (int rep = 0, nrep = (((REPEAT_MASK >> step) & 1u) ? 2 : 1); rep < nrep; ++rep) {
        int layer, sub;
        if (step < 6) { layer = 0; sub = step - 1; } else if (step < 13) { layer = 1; sub = step - 6; } else if (step < 18) { layer = 2; sub = step - 13; } else { layer = 3; sub = step - 18; }
        const bool odd = layer & 1; const int nsub = odd ? 7 : 5;
#ifndef NO_PRO
        if (step == 0) prologue(a, lds);
        else
#endif
        if (step == 25) final_norm(a);
        else if (sub == 0 || sub >= nsub - 3) {
            pg8::Gemm g; EpiX E; E.mode = 0; E.O = nullptr; E.ldc = 0; E.ssq_in = nullptr; E.base = nullptr; E.xout = nullptr; E.ssq_out = nullptr;
            const int half = layer >> 1;
            if (sub == 0) {
                g.A = XB; g.M = T_TOK; g.K = 1024;
                if (!odd) { g.Bt = (const bf16*)(ws + WS_WAB_IN) + (size_t)half * 2048 * 1024; g.N = AB_N; } else { g.Bt = (const bf16*)(ws + WS_WGLA_IN) + (size_t)half * GLA_NP * 1024; g.N = GLA_NP; }
                E.mode = 0; E.O = R; E.ldc = g.N; E.ssq_in = ssq + (size_t)((2 * layer) & 1) * T_TOK * 16;
            } else if (sub == nsub - 3) {
                g.A = CAT; g.M = T_TOK; g.K = 1024; g.N = 1024;
                g.Bt = (!odd ? (const bf16*)(ws + WS_WAB_OUT) : (const bf16*)(ws + WS_WGLA_OUT)) + (size_t)half * 1024 * 1024;
                E.mode = 2; E.O = XB; E.ldc = 1024; E.base = (layer == 0) ? a.in[0] : a.out; E.xout = a.out; E.ssq_out = ssq + (size_t)((2 * layer + 1) & 1) * T_TOK * 16;
            } else if (sub == nsub - 2) {
                g.A = XB; g.M = T_TOK; g.K = 1024; g.N = DFF; g.Bt = (const bf16*)(ws + WS_W1) + (size_t)layer * 4096 * 1024;
                E.mode = 1; E.O = R; E.ldc = DFF; E.ssq_in = ssq + (size_t)((2 * layer + 1) & 1) * T_TOK * 16;
            } else {
                g.A = R; g.M = T_TOK; g.K = DFF; g.N = 1024; g.Bt = (const bf16*)(ws + WS_W2) + (size_t)layer * 1024 * 4096;
                E.mode = 2; E.O = XB; E.ldc = 1024; E.base = a.out; E.xout = a.out; E.ssq_out = ssq + (size_t)((2 * layer + 2) & 1) * T_TOK * 16;
            }
            pg8::StaticOrder S; S.init(g.M, g.N, (int)gridDim.x, (int)blockIdx.x);
#ifndef NO_GEMM
            pg8::gemm_phase<EpiX, pg8::StaticOrder, true, true>(lds, g, S, E);
#endif
        }
#ifndef NO_ATTN
        else if (!odd) attn_phase(a, lds, layer);
#endif
#ifndef NO_G1
        else if (sub == 1) gla_g1(a, lds, layer >> 1);
#endif
#ifndef NO_G2
        else if (sub == 2) gla_g2(a);
#endif
#ifndef NO_G3
        else if (sub == 3) gla_g3(a, lds, layer >> 1);
#endif
        if (step + 1 < a.ph_hi || rep + 1 < nrep) {
            xcd_barrier(bar);
        }
    }
}

#ifndef N_LAUNCH_SPLIT
#define N_LAUNCH_SPLIT 0
#endif
extern "C" void kernel_launch(void* const* d_in, const int* in_sizes, int n_in, void* d_out, int out_size, void* d_ws, size_t ws_size, hipStream_t stream) {
    static int grid = 0;
    if (grid == 0) {
        if (n_in != 17 || out_size != T_TOK * DM || ws_size < WS_END) { fprintf(stderr, "kernel_launch: unexpected shapes / workspace (%d inputs, out %d, ws %zu)\n", n_in, out_size, ws_size); grid = -1; return; }
        int dev = 0, cus = 0, per_cu = 0;
        hipGetDevice(&dev);
        hipDeviceGetAttribute(&cus, hipDeviceAttributeMultiprocessorCount, dev);
        if (hipFuncSetAttribute((const void*)mega_fwd, hipFuncAttributeMaxDynamicSharedMemorySize, LDS_BYTES) != hipSuccess) { fprintf(stderr, "kernel_launch: hipFuncSetAttribute failed\n"); grid = -1; return; }
        if (hipOccupancyMaxActiveBlocksPerMultiprocessor(&per_cu, (const void*)mega_fwd, 512, LDS_BYTES) != hipSuccess || per_cu < 1) per_cu = 1;
        (void)hipGetLastError();
        grid = cus * per_cu;
        if (grid > 256) grid = 256;
    }
    if (grid < 0) return;
    if (hipMemsetAsync((char*)d_ws + WS_CTL, 0, CTL_BYTES, stream) != hipSuccess) { fprintf(stderr, "kernel_launch: memset failed\n"); return; }
    Args a{};
    for (int i = 0; i < 17; ++i) a.in[i] = (const float*)d_in[i];
    a.out = (float*)d_out; a.ws = (unsigned char*)d_ws;
#if N_LAUNCH_SPLIT
    for (int s = 0; s < NSTEPS; ++s) { a.ph_lo = s; a.ph_hi = s + 1; void* args[] = {&a};
        hipError_t e = hipLaunchCooperativeKernel((const void*)mega_fwd, dim3(grid), dim3(512), args, LDS_BYTES, stream);
        if (e != hipSuccess) { fprintf(stderr, "launch %d failed: %s\n", s, hipGetErrorString(e)); break; } }
#else
    a.ph_lo = 0; a.ph_hi = NSTEPS; void* args[] = {&a};
    hipError_t e = hipLaunchCooperativeKernel((const void*)mega_fwd, dim3(grid), dim3(512), args, LDS_BYTES, stream);
    if (e != hipSuccess) fprintf(stderr, "cooperative launch failed: %s (grid %d)\n", hipGetErrorString(e), grid);
#endif
}
```

```cpp
#include <hip/hip_runtime.h>
#include <hip/hip_cooperative_groups.h>
#include <cstdio>
#include <cstdint>
namespace cg = cooperative_groups;
namespace pg8 {
#define PG8_LAS __attribute__((address_space(3)))
typedef unsigned short bf16_t;
typedef short bf16x8 __attribute__((ext_vector_type(8)));
typedef float f32x4 __attribute__((ext_vector_type(4)));
typedef unsigned u32x4 __attribute__((ext_vector_type(4)));
constexpr int BM = 256, BK = 64, HALF = 128, HTB = HALF * BK * 2  , STAGE_BYTES = 8 * HTB, NXCD = 8, WGM = 8;

__host__ __device__ __forceinline__ int lds_byte(int r, int c) { const int st = (r >> 4) * 2 + (c >> 5), rr = r & 15, cc = c & 31, ob = rr * 64 + cc * 2; return st * 1024 + (ob ^ (((ob >> 9) & 1) << 5)); }
__host__ __device__ __forceinline__ void stage_rc(int b, int& R, int& C) { const int st = b / 1024, sb = b % 1024, swz = sb ^ (((sb >> 9) & 1) << 5); R = (st >> 1) * 16 + swz / 64; C = (st & 1) * 32 + (swz % 64) / 2; }
__host__ __device__ __forceinline__ int perm32(int rho) { const int n = rho >> 4, i = rho & 15; return 8 * (i >> 2) + 4 * n + (i & 3); }

struct Unit { int pm, pn; };
struct Gemm { const bf16_t* A; const bf16_t* Bt; int M, N, K; };

struct StaticOrder {
    int nM, nN, nwg, G, c;
    __host__ __device__ void init(int M, int N, int G_, int c_) { nM = M / BM; nN = N / BM; nwg = nM * nN; G = G_; c = c_; }
    __host__ __device__ bool next(int i, Unit& u) const {
        const long L = (long)i * G + c; if (L >= nwg) return false;
        int wgid = (int)L; { const int q = nwg / NXCD, r = nwg % NXCD, xcd = wgid % NXCD, off = wgid / NXCD; wgid = (xcd < r ? xcd * (q + 1) : r * (q + 1) + (xcd - r) * q) + off; }
        const int nig = WGM * nN, gid = wgid / nig, fm = gid * WGM, gsz = (nM - fm) < WGM ? (nM - fm) : WGM;
        u.pm = fm + ((wgid % nig) % gsz); u.pn = (wgid % nig) / gsz; return true;
    }
    __device__ __forceinline__ void a_ready(const Unit&) const {}
    __device__ __forceinline__ void done(const Unit&) const {}
};
__device__ __forceinline__ unsigned cvt_pk_bf16(float lo, float hi) { unsigned r; asm volatile("v_cvt_pk_bf16_f32 %0, %1, %2" : "=v"(r) : "v"(lo), "v"(hi)); return r; }
typedef float f32x2 __attribute__((ext_vector_type(2)));
template <class Epi, class Sched, bool ALIGN_EPI = false, bool SP2 = false>
__device__ __forceinline__ void gemm_phase(PG8_LAS unsigned char* lds, const Gemm g, const Sched& S, const Epi& E) {
    int tid_ = threadIdx.x; asm volatile("" : "+v"(tid_));
    const int tid = tid_, wid = __builtin_amdgcn_readfirstlane(tid >> 6), lane = tid & 63, wr = wid >> 2, wc = wid & 3, fr = lane & 15, fq = lane >> 4;
    const int K = g.K, nt = K / BK;
    unsigned voffA[2], voffB[2];
#pragma unroll
    for (int i = 0; i < 2; ++i) { int R, C; stage_rc(tid * 16 + i * 8192, R, C); const int Rb = Epi::PERM ? ((R & ~31) + perm32(R & 31)) : R;
        voffA[i] = (unsigned)(R * K + C) * 2u; voffB[i] = (unsigned)(Rb * K + C) * 2u; }
    const size_t kstep = (size_t)(BK * 2);
    const size_t hstep = (size_t)HALF * K * 2;
    const size_t tstep = 2 * hstep;
    const unsigned ldsw = (unsigned)wid * 1024u;
    const int aoff = lds_byte(wr * 64 + fr, fq * 8), boff = lds_byte(wc * 32 + fr, fq * 8);
#define PG8_SA(b, h) (((b) * 2 + (h)) * HTB)
#define PG8_SB(b, h) ((4 + (b) * 2 + (h)) * HTB)
#define PG8_STAGE(bufoff, gbase, voff) do { _Pragma("unroll") for (int _i = 0; _i < 2; ++_i) \
        __builtin_amdgcn_global_load_lds((const unsigned*)((const char*)(gbase) + (voff)[_i]), (PG8_LAS unsigned*)(lds + (bufoff) + ldsw + _i * 8192), 16, 0, 0); } while (0)
#define PG8_LDA(dst, b, h) do { _Pragma("unroll") for (int m = 0; m < 4; ++m) _Pragma("unroll") for (int k = 0; k < 2; ++k) dst[m][k] = *(const PG8_LAS bf16x8*)(lds + PG8_SA(b, h) + aoff + m * 2048 + k * 1024); } while (0)
#define PG8_LDB(dst, b, h) do { _Pragma("unroll") for (int n = 0; n < 2; ++n) _Pragma("unroll") for (int k = 0; k < 2; ++k) dst[n][k] = *(const PG8_LAS bf16x8*)(lds + PG8_SB(b, h) + boff + n * 2048 + k * 1024); } while (0)
#define PG8_MMA(ai, bj, At, Bt) do { __builtin_amdgcn_s_setprio(1); _Pragma("unroll") for (int m = 0; m < 4; ++m) _Pragma("unroll") for (int n = 0; n < 2; ++n) _Pragma("unroll") for (int k = 0; k < 2; ++k) \
        acc[ai][bj][m][n] = __builtin_amdgcn_mfma_f32_16x16x32_bf16(Bt[n][k], At[m][k], acc[ai][bj][m][n], 0, 0, 0); __builtin_amdgcn_s_setprio(0); } while (0)
#define PG8_WAIT_V(n) asm volatile("s_waitcnt vmcnt(" #n ")" ::: "memory")
#define PG8_WAIT_L(n) asm volatile("s_waitcnt lgkmcnt(" #n ")" ::: "memory")
#define PG8_BAR __builtin_amdgcn_s_barrier()
#define PG8_SCHED __builtin_amdgcn_sched_barrier(0)
    Unit cur, nxt; int ui = 0;
    if (!S.next(0, cur)) return;
    f32x4 acc[2][2][4][2];
#pragma unroll
    for (int a = 0; a < 2; ++a)
#pragma unroll
        for (int b = 0; b < 2; ++b)
#pragma unroll
            for (int m = 0; m < 4; ++m)
#pragma unroll
                for (int n = 0; n < 2; ++n) acc[a][b][m][n] = (f32x4){0.f, 0.f, 0.f, 0.f};
    bf16x8 At[4][2], B0[2][2], B1[2][2];
    const char* cA = (const char*)g.A + (size_t)cur.pm * tstep; const char* cB = (const char*)g.Bt + (size_t)cur.pn * tstep;
    S.a_ready(cur);
    if constexpr (SP2) {
        PG8_STAGE(PG8_SB(0, 0), cB, voffB); PG8_STAGE(PG8_SB(0, 1), cB + hstep, voffB); PG8_STAGE(PG8_SA(0, 0), cA, voffA); PG8_STAGE(PG8_SA(0, 1), cA + hstep, voffA);
        if (wr == 1) PG8_BAR;
        PG8_WAIT_V(2); PG8_BAR;
        PG8_STAGE(PG8_SB(1, 0), cB + kstep, voffB); PG8_STAGE(PG8_SA(1, 0), cA + kstep, voffA); PG8_STAGE(PG8_SB(1, 1), cB + hstep + kstep, voffB);
        PG8_WAIT_V(6); PG8_BAR;
    } else {
        PG8_STAGE(PG8_SB(0, 0), cB, voffB); PG8_STAGE(PG8_SA(0, 0), cA, voffA); PG8_STAGE(PG8_SB(0, 1), cB + hstep, voffB); PG8_STAGE(PG8_SA(0, 1), cA + hstep, voffA);
        if (wr == 1) PG8_BAR;
        PG8_WAIT_V(4); PG8_BAR;
        PG8_STAGE(PG8_SB(1, 0), cB + kstep, voffB); PG8_STAGE(PG8_SA(1, 0), cA + kstep, voffA); PG8_STAGE(PG8_SB(1, 1), cB + hstep + kstep, voffB);
        PG8_WAIT_V(6); PG8_BAR;
    }
    for (;;) {
        const bool has_next = S.next(ui + 1, nxt);
        const char* nA = has_next ? (const char*)g.A + (size_t)nxt.pm * tstep : cA; const char* nB = has_next ? (const char*)g.Bt + (size_t)nxt.pn * tstep : cB;
        for (int t = 0; t < nt; t += 2) {
            const bool last = (t == nt - 2);
            const char* a1 = cA + (size_t)(t + 1) * kstep;
            const char* a2 = last ? nA : cA + (size_t)(t + 2) * kstep; const char* b2 = last ? nB : cB + (size_t)(t + 2) * kstep;
            const char* a3 = a2 + kstep; const char* b3 = b2 + kstep;
            if (last && has_next) S.a_ready(nxt);
            if constexpr (SP2) {
            PG8_LDB(B0, 0, 0); PG8_LDB(B1, 0, 1); PG8_SCHED; PG8_LDA(At, 0, 0); PG8_STAGE(PG8_SA(1, 1), a1 + hstep, voffA);
            PG8_WAIT_V(8); PG8_WAIT_L(0); PG8_BAR; PG8_MMA(0, 0, At, B0); PG8_MMA(0, 1, At, B1); PG8_BAR; PG8_SCHED;
            PG8_LDA(At, 0, 1); PG8_STAGE(PG8_SB(0, 0), b2, voffB); PG8_STAGE(PG8_SB(0, 1), b2 + hstep, voffB); PG8_STAGE(PG8_SA(0, 0), a2, voffA);
            PG8_WAIT_V(8); PG8_WAIT_L(0); PG8_BAR; PG8_MMA(1, 0, At, B0); PG8_MMA(1, 1, At, B1); PG8_BAR; PG8_SCHED;
            PG8_LDB(B0, 1, 0); PG8_LDB(B1, 1, 1); PG8_SCHED; PG8_LDA(At, 1, 0); PG8_STAGE(PG8_SA(0, 1), a2 + hstep, voffA);
            PG8_WAIT_V(8); PG8_WAIT_L(0); PG8_BAR; PG8_MMA(0, 0, At, B0); PG8_MMA(0, 1, At, B1); PG8_BAR; PG8_SCHED;
            PG8_LDA(At, 1, 1); PG8_STAGE(PG8_SB(1, 0), b3, voffB); PG8_STAGE(PG8_SB(1, 1), b3 + hstep, voffB); PG8_STAGE(PG8_SA(1, 0), a3, voffA);
            PG8_WAIT_V(8); PG8_WAIT_L(0); PG8_BAR; PG8_MMA(1, 0, At, B0); PG8_MMA(1, 1, At, B1); PG8_BAR; PG8_SCHED;
            } else {
            PG8_LDB(B0, 0, 0); PG8_SCHED; PG8_LDA(At, 0, 0); PG8_STAGE(PG8_SA(1, 1), a1 + hstep, voffA);
            PG8_WAIT_L(8); PG8_BAR; PG8_WAIT_L(0); PG8_MMA(0, 0, At, B0); PG8_BAR; PG8_SCHED;
            PG8_LDB(B1, 0, 1); PG8_STAGE(PG8_SB(0, 0), b2, voffB);
            PG8_BAR; PG8_WAIT_L(0); PG8_MMA(0, 1, At, B1); PG8_BAR;
            PG8_LDA(At, 0, 1); PG8_STAGE(PG8_SA(0, 0), a2, voffA);
            PG8_BAR; PG8_WAIT_L(0); PG8_MMA(1, 0, At, B0); PG8_BAR; PG8_SCHED;
            PG8_STAGE(PG8_SB(0, 1), b2 + hstep, voffB);
            PG8_WAIT_V(6); PG8_BAR; PG8_MMA(1, 1, At, B1); PG8_BAR;
            PG8_LDB(B0, 1, 0); PG8_SCHED; PG8_LDA(At, 1, 0); PG8_STAGE(PG8_SA(0, 1), a2 + hstep, voffA);
            PG8_WAIT_L(8); PG8_BAR; PG8_WAIT_L(0); PG8_MMA(0, 0, At, B0); PG8_BAR; PG8_SCHED;
            PG8_LDB(B1, 1, 1); PG8_STAGE(PG8_SB(1, 0), b3, voffB);
            PG8_BAR; PG8_WAIT_L(0); PG8_MMA(0, 1, At, B1); PG8_BAR;
            PG8_LDA(At, 1, 1); PG8_STAGE(PG8_SA(1, 0), a3, voffA);
            PG8_BAR; PG8_WAIT_L(0); PG8_MMA(1, 0, At, B0); PG8_BAR; PG8_SCHED;
            PG8_STAGE(PG8_SB(1, 1), b3 + hstep, voffB);
            PG8_WAIT_V(6); PG8_BAR; PG8_MMA(1, 1, At, B1); PG8_BAR;
            }
        }
        if constexpr (ALIGN_EPI) { if (wr == 0) PG8_BAR; }
        if constexpr (!Epi::AFTER_DRAIN) { E(acc, cur, wr, wc, fr, fq); S.done(cur); }
        if (!has_next) break;
#pragma unroll
        for (int a = 0; a < 2; ++a)
#pragma unroll
            for (int b = 0; b < 2; ++b)
#pragma unroll
                for (int m = 0; m < 4; ++m)
#pragma unroll
                    for (int n = 0; n < 2; ++n) acc[a][b][m][n] = (f32x4){0.f, 0.f, 0.f, 0.f};
        cur = nxt; cA = nA; cB = nB; ++ui;
        if constexpr (ALIGN_EPI) { if (wr == 1) PG8_BAR; }
    }
    PG8_WAIT_V(0);
    if constexpr (!ALIGN_EPI) { if (wr == 0) PG8_BAR; }
    PG8_BAR;
    if constexpr (Epi::AFTER_DRAIN) { E.fused(acc, cur, wr, wc, fr, fq, lds, wid, lane); S.done(cur); }
#undef PG8_SA
#undef PG8_SB
#undef PG8_STAGE
#undef PG8_LDA
#undef PG8_LDB
#undef PG8_MMA
#undef PG8_WAIT_V
#undef PG8_WAIT_L
#undef PG8_BAR
#undef PG8_SCHED
}
}

#define LAS __attribute__((address_space(3)))
#define GAS __attribute__((address_space(1)))
typedef unsigned short bf16;
typedef short bf16x8 __attribute__((ext_vector_type(8)));
typedef float f32x4 __attribute__((ext_vector_type(4)));
typedef float f32x16 __attribute__((ext_vector_type(16)));
typedef unsigned u32x4 __attribute__((ext_vector_type(4)));
typedef unsigned u32x2 __attribute__((ext_vector_type(2)));
typedef short v4i16_t __attribute__((ext_vector_type(4)));
typedef float f32x2_t __attribute__((ext_vector_type(2)));
typedef __bf16 bf16x2_t __attribute__((ext_vector_type(2)));

constexpr int T_TOK = 32768, DM = 1024, SEQ = 8192, DFF = 4096;
constexpr int AB_N = 2048, GLA_N = 3088, GLA_NP = 3328;
constexpr float RMS_EPS = 1e-6f;
constexpr float QK_C2 = 0.125f * 1.4426950408889634f;
constexpr size_t MiB = 1u << 20;
constexpr size_t WS_WAB_IN = 0, WS_WAB_OUT = 8 * MiB, WS_WGLA_IN = 12 * MiB, WS_WGLA_OUT = 25 * MiB, WS_W1 = 29 * MiB, WS_W2 = 61 * MiB;
constexpr size_t WS_SSQ = 480 * MiB  , WS_DEC = 95 * MiB, WS_XB = 96 * MiB, WS_CAT = 160 * MiB, WS_R = 224 * MiB;
constexpr size_t WS_STASH = WS_R + 128 * MiB, WS_UHI = WS_R + 208 * MiB, WS_END = 496 * MiB;
constexpr size_t WS_CTL = 93 * MiB, CTL_BYTES = 16384, WS_WUPT = 93 * MiB + 65536;
constexpr int LDS_BYTES = 147456, LDS_BARST = 131072 + 1024;
constexpr int NSTEPS = 26;

__device__ __forceinline__ unsigned f2bf(float f) { unsigned u = __builtin_bit_cast(unsigned, f); return (u + 0x7fffu + ((u >> 16) & 1u)) >> 16; }
__device__ __forceinline__ unsigned pk2(float lo, float hi) { f32x2_t v = {lo, hi}; bf16x2_t b = __builtin_convertvector(v, bf16x2_t); return __builtin_bit_cast(unsigned, b); }
__device__ __forceinline__ float bf2f(unsigned short u) { return __builtin_bit_cast(float, (unsigned)u << 16); }
__device__ __forceinline__ float bflo(unsigned u) { return __builtin_bit_cast(float, u << 16); }
__device__ __forceinline__ float bfhi(unsigned u) { return __builtin_bit_cast(float, u & 0xffff0000u); }
__device__ __forceinline__ int crow(int r, int hi) { return (r & 3) + 8 * (r >> 2) + 4 * hi; }
__device__ __forceinline__ bf16x8 pack8(float a0, float a1, float a2, float a3, float a4, float a5, float a6, float a7) {
    u32x4 w; w.x = pk2(a0, a1); w.y = pk2(a2, a3); w.z = pk2(a4, a5); w.w = pk2(a6, a7); return __builtin_bit_cast(bf16x8, w);
}
__device__ __forceinline__ v4i16_t trrd(const LAS unsigned char* p) { return __builtin_amdgcn_ds_read_tr16_b64_v4i16((LAS v4i16_t*)p); }
__device__ __forceinline__ bf16x8 cat44(v4i16_t lo, v4i16_t hi) { return (bf16x8){lo[0], lo[1], lo[2], lo[3], hi[0], hi[1], hi[2], hi[3]}; }
template <class T> __device__ __forceinline__ T gld(const T* p) { return *(const GAS T*)p; }
template <class T> __device__ __forceinline__ void gst(T* p, T v) { *(GAS T*)p = v; }
#define MFMA32(a, b, c) __builtin_amdgcn_mfma_f32_32x32x16_bf16((a), (b), (c), 0, 0, 0)


__device__ __forceinline__ int otid() { int t = threadIdx.x; asm volatile("" : "+v"(t)); return t; }
template <class P> __device__ __forceinline__ P* optr(P* p) { asm volatile("" : "+s"(p)); return p; }
struct EpiX {
    static constexpr bool PERM = true, AFTER_DRAIN = false;
    int mode;
    bf16* O; int ldc;
    const float* ssq_in;
    const float* base; float* xout; float* ssq_out;
    __device__ __forceinline__ void operator()(const pg8::f32x4 (&acc)[2][2][4][2], const pg8::Unit& u, int wr, int wc, int fr, int fq) const {
        const int row0 = u.pm * 256 + wr * 64 + fr, col0 = u.pn * 256 + wc * 32 + 8 * fq;
        if (mode != 2) {
            const int lane = fq * 16 + fr;
            float rsv[2];
#pragma unroll
            for (int j = 0; j < 2; ++j) {
                const float* sp = ssq_in + (size_t)(u.pm * 256 + wr * 64 + j * 128 + lane) * 16;
                const f32x4 q0 = *(const GAS f32x4*)(sp), q1 = *(const GAS f32x4*)(sp + 4), q2 = *(const GAS f32x4*)(sp + 8), q3 = *(const GAS f32x4*)(sp + 12);
                const float tot = (((q0[0] + q0[1]) + (q0[2] + q0[3])) + ((q1[0] + q1[1]) + (q1[2] + q1[3]))) + (((q2[0] + q2[1]) + (q2[2] + q2[3])) + ((q3[0] + q3[1]) + (q3[2] + q3[3])));
                rsv[j] = rsqrtf(tot * (1.0f / 1024.0f) + RMS_EPS);
            }
#pragma unroll
            for (int ai = 0; ai < 2; ++ai)
#pragma unroll
                for (int m = 0; m < 4; ++m) {
                    const int row = row0 + ai * 128 + m * 16;
                    const float rs = __shfl(rsv[ai], m * 16 + fr);
#pragma unroll
                    for (int bj = 0; bj < 2; ++bj) {
                        f32x4 v0 = acc[ai][bj][m][0] * rs, v1 = acc[ai][bj][m][1] * rs;
                        if (mode == 1) {
#pragma unroll
                            for (int i = 0; i < 4; ++i) { float a = fmaxf(v0[i], 0.f), b = fmaxf(v1[i], 0.f); v0[i] = a * a; v1[i] = b * b; }
                        }
                        u32x4 w; w.x = pk2(v0[0], v0[1]); w.y = pk2(v0[2], v0[3]); w.z = pk2(v1[0], v1[1]); w.w = pk2(v1[2], v1[3]);
                        *(GAS u32x4*)(O + (size_t)row * ldc + col0 + bj * 128) = w;
                    }
                }
        } else {
#pragma unroll
            for (int ai = 0; ai < 2; ++ai) {
                u32x4 bb[4][2];
#pragma unroll
                for (int m = 0; m < 4; ++m)
#pragma unroll
                    for (int bj = 0; bj < 2; ++bj) bb[m][bj] = *(const GAS u32x4*)(O + (size_t)(row0 + ai * 128 + m * 16) * 1024 + col0 + bj * 128);
#pragma unroll
                for (int m = 0; m < 4; ++m) {
                    const int row = row0 + ai * 128 + m * 16;
                    float ss = 0.f;
#pragma unroll
                    for (int bj = 0; bj < 2; ++bj) {
                        const size_t off = (size_t)row * 1024 + col0 + bj * 128;
                        const u32x4 b = bb[m][bj];
                        const f32x4 x0 = (f32x4){bflo(b.x), bfhi(b.x), bflo(b.y), bfhi(b.y)} + acc[ai][bj][m][0];
                        const f32x4 x1 = (f32x4){bflo(b.z), bfhi(b.z), bflo(b.w), bfhi(b.w)} + acc[ai][bj][m][1];
                        u32x4 w; w.x = pk2(x0[0], x0[1]); w.y = pk2(x0[2], x0[3]); w.z = pk2(x1[0], x1[1]); w.w = pk2(x1[2], x1[3]);
                        *(GAS u32x4*)(O + off) = w;
                        ss += (x0[0] * x0[0] + x0[1] * x0[1]) + (x0[2] * x0[2] + x0[3] * x0[3]) + (x1[0] * x1[0] + x1[1] * x1[1]) + (x1[2] * x1[2] + x1[3] * x1[3]);
                    }
                    ss += __shfl_xor(ss, 16); ss += __shfl_xor(ss, 32);
                    if (fq == 0) *(GAS float*)(ssq_out + (size_t)row * 16 + u.pn * 4 + wc) = ss;
                }
                asm volatile("" ::: "memory");
            }
        }
    }
};

struct Args { const float* in[17]; float* out; unsigned char* ws; int ph_lo, ph_hi; };

__device__ __forceinline__ void transpose_item(const float* __restrict__ W, int ldw, int nvalid, const float* __restrict__ gain, float qscale, int nq,
                                               bf16* __restrict__ WT, int ldt, int k0, int n0, LAS float* scr, int lane) {
    const int cq = 4 * (lane & 7), nc = n0 + cq;
    f32x4 v[8];
#pragma unroll
    for (int j = 0; j < 8; ++j) {
        const float* src = W + (size_t)(k0 + 8 * j + (lane >> 3)) * ldw + nc;
        if (nc + 3 < nvalid) v[j] = __builtin_nontemporal_load((const GAS f32x4*)src);
        else { v[j] = (f32x4){0.f, 0.f, 0.f, 0.f};
#pragma unroll
            for (int e = 0; e < 4; ++e) if (nc + e < nvalid) v[j][e] = *(const GAS float*)(src + e); }
    }
#pragma unroll
    for (int j = 0; j < 8; ++j) {
        const int kk = 8 * j + (lane >> 3);
        const float gsc = gain ? *(const GAS float*)(gain + k0 + kk) : 1.0f;
#pragma unroll
        for (int e = 0; e < 4; ++e) scr[kk * 33 + cq + e] = v[j][e] * gsc * ((nc + e < nq) ? qscale : 1.0f);
    }
    asm volatile("s_waitcnt lgkmcnt(0)" ::: "memory");
    const int c = lane & 7;
#pragma unroll
    for (int j = 0; j < 4; ++j) {
        const int nn = (lane >> 3) + 8 * j; const LAS float* s = scr + (8 * c) * 33 + nn;
        u32x4 o; o.x = pk2(s[0 * 33], s[1 * 33]); o.y = pk2(s[2 * 33], s[3 * 33]); o.z = pk2(s[4 * 33], s[5 * 33]); o.w = pk2(s[6 * 33], s[7 * 33]);
        __builtin_nontemporal_store(o, (GAS u32x4*)(WT + (size_t)(n0 + nn) * ldt + k0 + 8 * c));
    }
    asm volatile("s_waitcnt lgkmcnt(0)" ::: "memory");
}

__device__ __forceinline__ float wave_sum(float v) {
#pragma unroll
    for (int o = 1; o < 64; o <<= 1) v += __shfl_xor(v, o);
    return v;
}

__device__ __forceinline__ void prologue(const Args& a, LAS unsigned char* lds) {
    const int tid = otid(), lane = tid & 63, wave = __builtin_amdgcn_readfirstlane(tid >> 6);
    const int gw = blockIdx.x * 8 + wave, NGW = gridDim.x * 8;
    const int gt = blockIdx.x * 512 + tid, NGT = gridDim.x * 512;
    unsigned char* ws = optr(a.ws);
    LAS float* scr = (LAS float*)(lds + wave * 16384);
    const float* norm_mix = a.in[1]; const float* norm_ffn = a.in[2];
    constexpr int I0 = 2048, I1 = 512, I2 = 3104, I3 = 1024, I4 = 8192, I5 = 8192;
    for (int it = gw; it < I0 + I1 + I2 + I3 + I4 + I5; it += NGW) {
        int r = it;
        if (r < I0) { const int e = r >> 10, q = r & 1023, kb = q >> 6, nb = q & 63;
            transpose_item(a.in[4] + (size_t)e * 1024 * 2048, 2048, 2048, norm_mix + (2 * e) * 1024, QK_C2, 512, (bf16*)(ws + WS_WAB_IN) + (size_t)e * 2048 * 1024, 1024, kb * 64, nb * 32, scr, lane); continue; }
        r -= I0;
        if (r < I1) { const int e = r >> 8, q = r & 255, kb = q >> 5, nb = q & 31;
            transpose_item(a.in[9] + (size_t)e * 1024 * 1024, 1024, 1024, nullptr, 1.f, 0, (bf16*)(ws + WS_WAB_OUT) + (size_t)e * 1024 * 1024, 1024, kb * 64, nb * 32, scr, lane); continue; }
        r -= I1;
        if (r < I2) { const int o = r / 1552, q = r % 1552, kb = q / 97, nb = q % 97;
            transpose_item(a.in[10] + (size_t)o * 1024 * GLA_N, GLA_N, GLA_N, norm_mix + (2 * o + 1) * 1024, 1.f, 0, (bf16*)(ws + WS_WGLA_IN) + (size_t)o * GLA_NP * 1024, 1024, kb * 64, nb * 32, scr, lane); continue; }
        r -= I2;
        if (r < I3) { const int o = r >> 9, q = r & 511, kb = q >> 5, nb = q & 31;
            transpose_item(a.in[14] + (size_t)o * 1024 * 1024, 1024, 1024, nullptr, 1.f, 0, (bf16*)(ws + WS_WGLA_OUT) + (size_t)o * 1024 * 1024, 1024, kb * 64, nb * 32, scr, lane); continue; }
        r -= I3;
        if (r < I4) { const int l = r >> 11, q = r & 2047, kb = q >> 7, nb = q & 127;
            transpose_item(a.in[15] + (size_t)l * 1024 * 4096, 4096, 4096, norm_ffn + l * 1024, 1.f, 0, (bf16*)(ws + WS_W1) + (size_t)l * 4096 * 1024, 1024, kb * 64, nb * 32, scr, lane); continue; }
        r -= I4;
        { const int l = r >> 11, q = r & 2047, kb = q >> 5, nb = q & 31;
            transpose_item(a.in[16] + (size_t)l * 4096 * 1024, 1024, 1024, nullptr, 1.f, 0, (bf16*)(ws + WS_W2) + (size_t)l * 1024 * 4096, 4096, kb * 64, nb * 32, scr, lane); }
    }
    for (int i = gt; i < 2 * 224 * 128; i += NGT) { const int o = i / (224 * 128), q = i % (224 * 128); unsigned zz; asm volatile("v_mov_b32 %0, 0" : "=v"(zz));
        *(u32x4*)((bf16*)(ws + WS_WGLA_IN) + (size_t)o * GLA_NP * 1024 + (size_t)3104 * 1024 + (size_t)q * 8) = (u32x4){zz, zz, zz, zz}; }
    for (int i = gt; i < 2 * 512 * 16; i += NGT) { const int o = i >> 13, n = (i >> 4) & 511, r = i & 15;
        ((bf16*)(ws + WS_WUPT))[i] = (bf16)f2bf(a.in[11][(size_t)o * 16 * 512 + r * 512 + n]); }
    for (int i = gt; i < 131072; i += NGT) {
        const int iw = __builtin_amdgcn_readfirstlane(i >> 10);
        const int e = iw >> 6, g = (iw >> 4) & 3, c8 = iw & 15, n = i & 1023;
        const float* pw = a.in[7] + ((size_t)(e * 4 + g) * 128 + c8 * 8) * 128;
        const float* sc = a.in[8] + e * 512 + g * 128;
        const float* wo = a.in[9] + (size_t)e * 1024 * 1024 + (size_t)(512 + g * 128) * 1024 + n;
        float acc[8] = {0.f, 0.f, 0.f, 0.f, 0.f, 0.f, 0.f, 0.f};
        for (int d0 = 0; d0 < 128; d0 += 16) {
            float w[16];
#pragma unroll
            for (int dd = 0; dd < 16; ++dd) w[dd] = *(const GAS float*)(wo + (size_t)(d0 + dd) * 1024);
#pragma unroll
            for (int dd = 0; dd < 16; ++dd) { const float ws_ = w[dd] * sc[d0 + dd];
#pragma unroll
                for (int j = 0; j < 8; ++j) acc[j] += pw[j * 128 + d0 + dd] * ws_; }
        }
        u32x4 o; o.x = pk2(acc[0], acc[1]); o.y = pk2(acc[2], acc[3]); o.z = pk2(acc[4], acc[5]); o.w = pk2(acc[6], acc[7]);
        *(u32x4*)((bf16*)(ws + WS_WAB_OUT) + (size_t)e * 1024 * 1024 + (size_t)n * 1024 + 512 + g * 128 + c8 * 8) = o;
    }
    float* ssq = (float*)(ws + WS_SSQ);
    for (int m = gw * 2; m < T_TOK; m += NGW * 2) {
        f32x4 v[2][4];
#pragma unroll
        for (int rr = 0; rr < 2; ++rr)
#pragma unroll
            for (int j = 0; j < 4; ++j) v[rr][j] = __builtin_nontemporal_load((const GAS f32x4*)(a.in[0] + (size_t)(m + rr) * 1024) + lane + 64 * j);
#pragma unroll
        for (int rr = 0; rr < 2; ++rr) {
            float s = 0.f;
            unsigned long long* o8 = (unsigned long long*)((bf16*)(ws + WS_XB) + (size_t)(m + rr) * 1024) + lane;
#pragma unroll
            for (int j = 0; j < 4; ++j) { const f32x4 q = v[rr][j]; s += (q.x * q.x + q.y * q.y) + (q.z * q.z + q.w * q.w);
                o8[64 * j] = (unsigned long long)pk2(q.x, q.y) | ((unsigned long long)pk2(q.z, q.w) << 32); }
            s = wave_sum(s);
            if (lane < 16) ssq[(size_t)(m + rr) * 16 + lane] = (lane == 0) ? s : 0.f;
        }
    }
}

__device__ __forceinline__ void final_norm(const Args& a) {
    const int tid = otid(), lane = tid & 63, wave = tid >> 6;
    const int gw = blockIdx.x * 8 + wave, NGW = gridDim.x * 8;
    const f32x4* gn = (const f32x4*)optr(a.in[3]);
    float* outp = optr(a.out);
    const bf16* xb = (const bf16*)(optr(a.ws) + WS_XB);
    for (int m = gw; m < T_TOK; m += NGW) {
        const u32x4 r0 = gld((const u32x4*)(xb + (size_t)m * 1024 + lane * 16)), r1 = gld((const u32x4*)(xb + (size_t)m * 1024 + lane * 16 + 8));
        float v[16] = {bflo(r0.x), bfhi(r0.x), bflo(r0.y), bfhi(r0.y), bflo(r0.z), bfhi(r0.z), bflo(r0.w), bfhi(r0.w),
                       bflo(r1.x), bfhi(r1.x), bflo(r1.y), bfhi(r1.y), bflo(r1.z), bfhi(r1.z), bflo(r1.w), bfhi(r1.w)};
        float s = 0.f;
#pragma unroll
        for (int j = 0; j < 16; ++j) s += v[j] * v[j];
        const float rs = rsqrtf(wave_sum(s) * (1.0f / 1024.0f) + RMS_EPS);
        f32x4* op = (f32x4*)(outp + (size_t)m * 1024 + lane * 16);
#pragma unroll
        for (int j = 0; j < 4; ++j) { const f32x4 g = gld(gn + lane * 4 + j); gst(op + j, (f32x4){v[4 * j] * rs * g[0], v[4 * j + 1] * rs * g[1], v[4 * j + 2] * rs * g[2], v[4 * j + 3] * rs * g[3]}); }
    }
}

template <int W> __device__ __forceinline__ void pool_item(const bf16* __restrict__ PROJ, bf16* __restrict__ CAT, int tb, int c8) {
    const int t0 = tb * 16; const bool first = ((t0 & (SEQ - 1)) == 0);
    const bf16* up = PROJ + (size_t)t0 * AB_N + 1536 + c8 * 8;
    u32x4 rows[15 + W];
#pragma unroll
    for (int k = 0; k < 15 + W; ++k) {
        const int dt = k - (W - 1);
        rows[k] = (dt < 0 && first) ? (u32x4){0u, 0u, 0u, 0u} : gld((const u32x4*)(up + (ptrdiff_t)dt * AB_N));
    }
    float rs[8] = {0.f, 0.f, 0.f, 0.f, 0.f, 0.f, 0.f, 0.f};
#pragma unroll
    for (int k = 0; k < W; ++k) { const u32x4 v = rows[k];
        rs[0] += bflo(v.x); rs[1] += bfhi(v.x); rs[2] += bflo(v.y); rs[3] += bfhi(v.y); rs[4] += bflo(v.z); rs[5] += bfhi(v.z); rs[6] += bflo(v.w); rs[7] += bfhi(v.w); }
#pragma unroll
    for (int i = 0; i < 16; ++i) {
        const u32x4 v = rows[W - 1 + i];
        const float u0[8] = {bflo(v.x), bfhi(v.x), bflo(v.y), bfhi(v.y), bflo(v.z), bfhi(v.z), bflo(v.w), bfhi(v.w)};
        const int cnt = first ? ((i + 1 < W) ? i + 1 : W) : W;
        const float inv = 1.0f / (float)cnt;
        u32x4 o; o.x = pk2(rs[0] * inv - u0[0], rs[1] * inv - u0[1]); o.y = pk2(rs[2] * inv - u0[2], rs[3] * inv - u0[3]);
        o.z = pk2(rs[4] * inv - u0[4], rs[5] * inv - u0[5]); o.w = pk2(rs[6] * inv - u0[6], rs[7] * inv - u0[7]);
        gst((u32x4*)(CAT + (size_t)(t0 + i) * 1024 + 512 + c8 * 8), o);
        if (i < 15) { const u32x4 a = rows[W + i], d = rows[i];
            rs[0] += bflo(a.x) - bflo(d.x); rs[1] += bfhi(a.x) - bfhi(d.x); rs[2] += bflo(a.y) - bflo(d.y); rs[3] += bfhi(a.y) - bfhi(d.y);
            rs[4] += bflo(a.z) - bflo(d.z); rs[5] += bfhi(a.z) - bfhi(d.z); rs[6] += bflo(a.w) - bflo(d.w); rs[7] += bfhi(a.w) - bfhi(d.w); }
    }
}
__device__ __forceinline__ void pool_phase(const bf16* __restrict__ PROJ, bf16* __restrict__ CAT) {
    const int gt = blockIdx.x * 512 + otid(), NGT = gridDim.x * 512;
    for (int i = gt; i < (T_TOK / 16) * 64; i += NGT) {
        const int tb = i >> 6, c8 = i & 63, g = c8 >> 4;
        if (g == 0) pool_item<2>(PROJ, CAT, tb, c8); else if (g == 1) pool_item<4>(PROJ, CAT, tb, c8); else if (g == 2) pool_item<8>(PROJ, CAT, tb, c8); else pool_item<16>(PROJ, CAT, tb, c8);
    }
}

constexpr int AT_KP = 144, AT_VP = 320, AT_KBUF = 64 * AT_KP, AT_VBUF = 64 * AT_VP, AT_QOFF = 2 * AT_KBUF + 2 * AT_VBUF;
#ifndef AT_SB1
#define AT_SB1
#endif
#ifndef AT_SB2
#define AT_SB2 __builtin_amdgcn_sched_barrier(0)
#endif
__device__ __forceinline__ void attn_unit(LAS unsigned char* lds, const bf16* __restrict__ PROJ, bf16* __restrict__ CAT, f32x4* stash,
                                          int b, int h, int qb, float lam, const float* __restrict__ subln, float oscale) {
    const int tid = otid(), lane = tid & 63, wid = __builtin_amdgcn_readfirstlane(tid >> 6), r32 = lane & 31, hi = lane >> 5;
    const size_t rowbase = (size_t)b * SEQ;
    const int NT = 4 * qb + 4, my_nt = 4 * qb + (wid >> 1) + 1;
    const size_t myrow = rowbase + (size_t)qb * 256 + wid * 32 + r32;
    const bf16* qrow = PROJ + myrow * AB_N + h * 128;
    const int krow = tid >> 3, kch = tid & 7, vrow = tid >> 4, vch = tid & 15;
    LAS unsigned char* kdst = lds + krow * AT_KP + kch * 16;
    LAS unsigned char* vdst = lds + 2 * AT_KBUF + vrow * AT_VP + vch * 16;
    const LAS unsigned char* kfb = lds + r32 * AT_KP + hi * 16;
    const LAS unsigned char* vfb = lds + 2 * AT_KBUF + (4 * hi + ((lane >> 2) & 3)) * AT_VP + (16 * ((lane >> 4) & 1) + 4 * (lane & 3)) * 2;
    f32x16 O[4];
#pragma nounroll
    for (int s = 0; s < 2; ++s) {
        bf16x8 qf[4];
#pragma unroll
        for (int ks = 0; ks < 4; ++ks) qf[ks] = gld((const bf16x8*)(qrow + s * 64 + ks * 16 + hi * 8));
        const bf16* kg = PROJ + (rowbase + krow) * AB_N + 512 + h * 128 + s * 64 + kch * 8;
        const bf16* vg = PROJ + (rowbase + vrow) * AB_N + 1024 + h * 128 + vch * 8;
        u32x4 kr = gld((const u32x4*)kg), vr0 = gld((const u32x4*)vg), vr1 = gld((const u32x4*)(vg + (size_t)32 * AB_N));
        *(LAS u32x4*)kdst = kr; *(LAS u32x4*)vdst = vr0; *(LAS u32x4*)(vdst + 32 * AT_VP) = vr1;
        { const size_t go = (size_t)64 * AB_N; kr = gld((const u32x4*)(kg + go)); vr0 = gld((const u32x4*)(vg + go)); vr1 = gld((const u32x4*)(vg + go + (size_t)32 * AB_N)); }
        __syncthreads();
        float m = 0.f, l = 0.f;
        f32x16 negm16;
#pragma unroll
        for (int r = 0; r < 16; ++r) negm16[r] = 0.f;
#pragma unroll
        for (int nb = 0; nb < 4; ++nb)
#pragma unroll
            for (int r = 0; r < 16; ++r) O[nb][r] = 0.f;
        for (int t = 0; t < NT; ++t) {
            const int cur = t & 1;
            const bool more = (t + 1 < NT), act = (t < my_nt);
            if (more) {
                const int nx = cur ^ 1;
                *(LAS u32x4*)(kdst + nx * AT_KBUF) = kr; *(LAS u32x4*)(vdst + nx * AT_VBUF) = vr0; *(LAS u32x4*)(vdst + nx * AT_VBUF + 32 * AT_VP) = vr1;
            }
            if (t + 2 < NT) {
                const size_t go = (size_t)(t + 2) * 64 * AB_N;
                kr = gld((const u32x4*)(kg + go)); vr0 = gld((const u32x4*)(vg + go)); vr1 = gld((const u32x4*)(vg + go + (size_t)32 * AB_N));
            }
            bf16x8 pf[4];
            if (act) {
                f32x16 p0, p1;
                const LAS unsigned char* kb = kfb + cur * AT_KBUF;
                p0 = MFMA32(*(const LAS bf16x8*)(kb), qf[0], negm16);
                p1 = MFMA32(*(const LAS bf16x8*)(kb + 32 * AT_KP), qf[0], negm16);
#pragma unroll
                for (int ks = 1; ks < 4; ++ks) {
                    p0 = MFMA32(*(const LAS bf16x8*)(kb + ks * 32), qf[ks], p0);
                    p1 = MFMA32(*(const LAS bf16x8*)(kb + 32 * AT_KP + ks * 32), qf[ks], p1);
                }
                if (t == 0) {
                    float mx = fmaxf(p0[0], p1[0]);
#pragma unroll
                    for (int r = 1; r < 16; ++r) mx = fmaxf(mx, fmaxf(p0[r], p1[r]));
                    mx = fmaxf(mx, __shfl_xor(mx, 32));
                    m = mx;
#pragma unroll
                    for (int r = 0; r < 16; ++r) negm16[r] = -mx;
#pragma unroll
                    for (int r = 0; r < 16; ++r) { p0[r] -= mx; p1[r] -= mx; }
                }
                float ls = 0.f;
#pragma unroll
                for (int r = 0; r < 16; ++r) { p0[r] = __builtin_amdgcn_exp2f(p0[r]); p1[r] = __builtin_amdgcn_exp2f(p1[r]); ls += p0[r] + p1[r]; }
                if (__builtin_amdgcn_ballot_w64(!(ls < 1073741824.0f)) != 0ull) {
                    const float lsr = ls + __shfl_xor(ls, 32);
                    float d = floorf(__log2f(fminf(lsr, 3.0e38f))); d = fmaxf(d, 0.f);
                    const float alpha = __builtin_amdgcn_exp2f(-d);
                    m += d; l *= alpha; ls *= alpha;
#pragma unroll
                    for (int r = 0; r < 16; ++r) negm16[r] = -m;
#pragma unroll
                    for (int r = 0; r < 16; ++r) { p0[r] *= alpha; p1[r] *= alpha; }
#pragma unroll
                    for (int nb = 0; nb < 4; ++nb)
#pragma unroll
                        for (int r = 0; r < 16; ++r) O[nb][r] *= alpha;
                }
                l += ls;
                pf[0] = pack8(p0[0], p0[1], p0[2], p0[3], p0[4], p0[5], p0[6], p0[7]);
                pf[1] = pack8(p0[8], p0[9], p0[10], p0[11], p0[12], p0[13], p0[14], p0[15]);
                pf[2] = pack8(p1[0], p1[1], p1[2], p1[3], p1[4], p1[5], p1[6], p1[7]);
                pf[3] = pack8(p1[8], p1[9], p1[10], p1[11], p1[12], p1[13], p1[14], p1[15]);
            }
            if (act) {
                const LAS unsigned char* vb = vfb + cur * AT_VBUF;
                v4i16_t vlo[2][4], vhi[2][4];
#pragma unroll
                for (int nb = 0; nb < 4; ++nb) { vlo[0][nb] = trrd(vb + nb * 64); vhi[0][nb] = trrd(vb + 8 * AT_VP + nb * 64); }
                __builtin_amdgcn_sched_barrier(0);
#pragma unroll
                for (int kk = 0; kk < 4; ++kk) {
                    if (kk < 3) {
#pragma unroll
                        for (int nb = 0; nb < 4; ++nb) { vlo[(kk + 1) & 1][nb] = trrd(vb + 16 * (kk + 1) * AT_VP + nb * 64); vhi[(kk + 1) & 1][nb] = trrd(vb + 16 * (kk + 1) * AT_VP + 8 * AT_VP + nb * 64); }
                    }
#pragma unroll
                    for (int nb = 0; nb < 4; ++nb) O[nb] = MFMA32(cat44(vlo[kk & 1][nb], vhi[kk & 1][nb]), pf[kk], O[nb]);
                    __builtin_amdgcn_sched_barrier(0);
                }
            }
            __syncthreads();
        }
        const float lt = l + __shfl_xor(l, 32);
        const float inv = 1.0f / lt;
#pragma unroll
        for (int nb = 0; nb < 4; ++nb)
#pragma unroll
            for (int r = 0; r < 16; ++r) O[nb][r] *= inv;
        f32x4* sp = stash + tid * 16;
        if (s == 0) {
#pragma unroll
            for (int nb = 0; nb < 4; ++nb)
#pragma unroll
                for (int q = 0; q < 4; ++q) gst(sp + nb * 4 + q, (f32x4){O[nb][4 * q], O[nb][4 * q + 1], O[nb][4 * q + 2], O[nb][4 * q + 3]});
        } else {
            float ss = 0.f, lamv = lam;
#pragma unroll
            for (int nb = 0; nb < 4; ++nb)
#pragma unroll
                for (int q = 0; q < 4; ++q) {
                    const f32x4 o1 = gld(sp + nb * 4 + q);
#pragma unroll
                    for (int i = 0; i < 4; ++i) { const float d = o1[i] - lamv * O[nb][4 * q + i]; O[nb][4 * q + i] = d; ss += d * d; }
                    asm volatile("" : "+v"(lamv), "+v"(O[nb][4 * q]), "+v"(O[nb][4 * q + 1]), "+v"(O[nb][4 * q + 2]), "+v"(O[nb][4 * q + 3]) :: "memory");
                }
            ss += __shfl_xor(ss, 32);
            float rs = rsqrtf(ss * (1.0f / 128.0f) + RMS_EPS) * oscale;
            bf16* orow = CAT + myrow * 1024 + h * 128;
#pragma unroll
            for (int nb = 0; nb < 4; ++nb)
#pragma unroll
                for (int q = 0; q < 4; ++q) {
                    const int dv = 32 * nb + 8 * q + 4 * hi;
                    const f32x4 gsub = gld((const f32x4*)(subln + dv));
                    u32x2 w; w.x = pk2(O[nb][4 * q] * rs * gsub[0], O[nb][4 * q + 1] * rs * gsub[1]); w.y = pk2(O[nb][4 * q + 2] * rs * gsub[2], O[nb][4 * q + 3] * rs * gsub[3]);
                    asm volatile("" : "+v"(rs), "+v"(w.x), "+v"(w.y));
                    gst((u32x2*)(orow + dv), w);
                }
        }
    }
}

__device__ __forceinline__ void attn_phase(const Args& a, LAS unsigned char* lds, int layer) {
    const int e = layer >> 1;
    unsigned char* wsl = optr(a.ws);
    const bf16* PROJ = (const bf16*)(wsl + WS_R); bf16* CAT = (bf16*)(wsl + WS_CAT);
    pool_phase(PROJ, CAT);
    const float* lp = a.in[5] + e * 256;
    float d1 = 0.f, d2 = 0.f;
    for (int i = 0; i < 64; ++i) { d1 += lp[i] * lp[64 + i]; d2 += lp[128 + i] * lp[192 + i]; }
    const float lam_init = 0.8f - 0.6f * expf(-0.3f * (float)layer);
    const float lam = expf(d1) - expf(d2) + lam_init;
    const float* subln = a.in[6] + e * 128;
    f32x4* stash_base = (f32x4*)(wsl + WS_STASH);
    int ord = 0;
    for (int pi = blockIdx.x; pi < 256; pi += gridDim.x, ++ord) {
        const int xcd = pi & 7, loc = pi >> 3, bh = xcd * 2 + (loc >> 4), j = loc & 15;
        const int b = bh >> 2, h = bh & 3;
        f32x4* st = stash_base + ((size_t)pi * 2) * 8192;
#pragma nounroll
        for (int u2 = 0; u2 < 2; ++u2) attn_unit(lds, PROJ, CAT, st + u2 * 8192, b, h, u2 ? j : 31 - j, lam, subln, 1.0f - lam_init);
    }
}

constexpr int GL_GKL = 0, GL_TOT = 4096, GL_SSQ = 6144, GL_V = 8192, GL_VP = 576, GL_A = GL_V + 64 * GL_VP  ;
constexpr int GL_KHP = 144, GL_QP = 272, GL_KT = GL_A + 64 * GL_QP, GL_QR = GL_KT + 64 * GL_QP  , GL_KR = GL_QR + 16384  ;
static_assert(GL_KR + 16384 <= 131072, "GLA LDS map");

__device__ __forceinline__ void gla_stage(LAS unsigned char* lds, const bf16* __restrict__ PROJ, size_t tok0, int h, int tid, bool with_q) {
#pragma unroll
    for (int i = 0; i < 2; ++i) {
        const int c = tid + 512 * i, row = c >> 4, ch = c & 15;
        *(LAS u32x4*)(lds + GL_KR + row * 256 + ch * 16) = gld((const u32x4*)(PROJ + (tok0 + row) * GLA_NP + 512 + h * 128 + ch * 8));
        if (with_q) *(LAS u32x4*)(lds + GL_QR + row * 256 + ch * 16) = gld((const u32x4*)(PROJ + (tok0 + row) * GLA_NP + h * 128 + ch * 8));
    }
    if (tid < 128) {
        const int row = tid >> 1, half = tid & 1;
        const u32x4 v = *(const u32x4*)(PROJ + (tok0 + row) * GLA_NP + 3072 + half * 8);
        *(LAS u32x4*)(lds + GL_GKL + row * 32 + half * 16) = v;
    }
#pragma unroll
    for (int i = 0; i < 4; ++i) {
        const int c = tid + 512 * i, row = c >> 5, ch = c & 31;
        const u32x4 v = *(const u32x4*)(PROJ + (tok0 + row) * GLA_NP + 1024 + h * 256 + ch * 8);
        *(LAS u32x4*)(lds + GL_V + row * GL_VP + ch * 16) = v;
    }
}
__device__ __forceinline__ void gla_gate(LAS unsigned char* lds, const bf16* __restrict__ wupT, const float* __restrict__ bgk, int h, int kd, int part, int tid, float (&bpre)[16], float& blast) {
    const int lane = tid & 63, wid = __builtin_amdgcn_readfirstlane(tid >> 6), r32 = lane & 31, hi = lane >> 5, tb = wid >> 2, kb = wid & 3;
    LAS float* L = (LAS float*)(lds + GL_A);
    {
        const bf16x8 af = *(const LAS bf16x8*)(lds + GL_GKL + (32 * tb + r32) * 32 + hi * 16);
        const bf16x8 bfr = gld((const bf16x8*)(wupT + (size_t)(h * 128 + 32 * kb + r32) * 16 + hi * 8));
        f32x16 acc;
#pragma unroll
        for (int r = 0; r < 16; ++r) acc[r] = 0.f;
        acc = MFMA32(af, bfr, acc);
        const float bias = bgk[h * 128 + 32 * kb + r32];
#pragma unroll
        for (int r = 0; r < 16; ++r) {
            const float x = acc[r] + bias;
            const float ls = fminf(x, 0.f) - __logf(1.0f + __expf(-fabsf(x)));
            L[(32 * tb + crow(r, hi)) * 128 + 32 * kb + r32] = ls * (1.0f / 16.0f);
        }
    }
    __syncthreads();
    LAS float* tot = (LAS float*)(lds + GL_TOT);
    float run = 0.f;
#pragma unroll
    for (int i = 0; i < 16; ++i) { run += L[(16 * part + i) * 128 + kd]; bpre[i] = run; }
    tot[part * 128 + kd] = run;
    __syncthreads();
    float off = 0.f, all = 0.f;
#pragma unroll
    for (int p = 0; p < 4; ++p) { const float v = tot[p * 128 + kd]; all += v; if (p < part) off += v; }
#pragma unroll
    for (int i = 0; i < 16; ++i) bpre[i] += off;
    blast = all;
}
__device__ __forceinline__ bf16* gla_ubase(unsigned char* ob, int unit) {
    return (bf16*)ob + (size_t)unit * 32768;
}

__device__ __forceinline__ void gla_g1(const Args& a, LAS unsigned char* lds, int o) {
    const int tid = otid(), lane = tid & 63, wid = __builtin_amdgcn_readfirstlane(tid >> 6), r32 = lane & 31, hi = lane >> 5;
    const int kd = tid & 127, part = tid >> 7;
    unsigned char* wsl = optr(a.ws); unsigned char* outl = (unsigned char*)optr(a.out);
    const bf16* PROJ = (const bf16*)(wsl + WS_R);
    const bf16* wupT = (const bf16*)(wsl + WS_WUPT) + (size_t)o * 512 * 16; const float* bgk = a.in[12] + o * 512;
    float* DEC = (float*)(wsl + WS_DEC);
    for (int unit = blockIdx.x; unit < 2048; unit += gridDim.x) {
        const int c = unit & 127, h = (unit >> 7) & 3, b = unit >> 9;
        const size_t tok0 = (size_t)b * SEQ + (size_t)c * 64;
        gla_stage(lds, PROJ, tok0, h, tid, false);
        __syncthreads();
        float bpre[16], blast;
        gla_gate(lds, wupT, bgk, h, kd, part, tid, bpre, blast);
        {
            const LAS unsigned short* kp = (const LAS unsigned short*)(lds + GL_KR + (16 * part) * 256) + kd;
            float kv[16];
#pragma unroll
            for (int i = 0; i < 16; ++i) kv[i] = bf2f(kp[i * 128]) * __expf(blast - bpre[i]);
            u32x4 w0, w1;
            w0.x = pk2(kv[0], kv[1]); w0.y = pk2(kv[2], kv[3]); w0.z = pk2(kv[4], kv[5]); w0.w = pk2(kv[6], kv[7]);
            w1.x = pk2(kv[8], kv[9]); w1.y = pk2(kv[10], kv[11]); w1.z = pk2(kv[12], kv[13]); w1.w = pk2(kv[14], kv[15]);
            LAS unsigned char* dst = lds + GL_A + kd * GL_KHP + part * 32;
            *(LAS u32x4*)dst = w0; *(LAS u32x4*)(dst + 16) = w1;
            if (part == 0) DEC[(size_t)unit * 128 + kd] = __expf(blast);
        }
        __syncthreads();
        bf16* ub = gla_ubase(outl, unit);
        const LAS unsigned char* vbp = lds + GL_V + (8 * hi + ((lane >> 2) & 3)) * GL_VP + (32 * wid + 16 * ((lane >> 4) & 1) + 4 * (lane & 3)) * 2;
#pragma unroll
        for (int kb = 0; kb < 4; ++kb) {
            f32x16 acc;
#pragma unroll
            for (int r = 0; r < 16; ++r) acc[r] = 0.f;
#pragma unroll
            for (int s = 0; s < 4; ++s) {
                const bf16x8 af = *(const LAS bf16x8*)(lds + GL_A + (32 * kb + r32) * GL_KHP + (16 * s + 8 * hi) * 2);
                const v4i16_t lo = trrd(vbp + 16 * s * GL_VP), hh = trrd(vbp + 16 * s * GL_VP + 4 * GL_VP);
                acc = MFMA32(af, cat44(lo, hh), acc);
            }
            bf16* up = ub + ((size_t)((kb * 8 + wid) * 2) * 64 + lane) * 8;
            *(bf16x8*)up = pack8(acc[0], acc[1], acc[2], acc[3], acc[4], acc[5], acc[6], acc[7]);
            *(bf16x8*)(up + 512) = pack8(acc[8], acc[9], acc[10], acc[11], acc[12], acc[13], acc[14], acc[15]);
        }
        __syncthreads();
    }
}

__device__ __forceinline__ void gla_g2(const Args& a) {
    unsigned char* wsl = optr(a.ws); unsigned char* outl = (unsigned char*)optr(a.out);
    const float* DEC = (const float*)(wsl + WS_DEC);
    const int tid_g2 = otid();
    if (tid_g2 < 256)
    for (int gt = blockIdx.x * 256 + tid_g2; gt < 65536; gt += gridDim.x * 256) {
        const int bh = gt >> 12, vec = gt & 4095, ln = vec & 63, s2 = (vec >> 6) & 1, kb = vec >> 10, hi = ln >> 5;
        const int kdA = 32 * kb + 16 * s2 + 4 * hi;
        float S[8] = {0.f, 0.f, 0.f, 0.f, 0.f, 0.f, 0.f, 0.f};
        for (int c0 = 0; c0 < 128; c0 += 8) {
            u32x4 uv[8]; f32x4 da[8], db[8];
#pragma unroll
            for (int i = 0; i < 8; ++i) {
                const int unit = bh * 128 + c0 + i;
                uv[i] = *(const u32x4*)(gla_ubase(outl, unit) + (size_t)vec * 8);
                da[i] = *(const f32x4*)(DEC + (size_t)unit * 128 + kdA); db[i] = *(const f32x4*)(DEC + (size_t)unit * 128 + kdA + 8);
            }
#pragma unroll
            for (int i = 0; i < 8; ++i) {
                const int unit = bh * 128 + c0 + i;
                u32x4 o; o.x = pk2(S[0], S[1]); o.y = pk2(S[2], S[3]); o.z = pk2(S[4], S[5]); o.w = pk2(S[6], S[7]);
                *(u32x4*)(gla_ubase(outl, unit) + (size_t)vec * 8) = o;
                S[0] = S[0] * da[i][0] + bflo(uv[i].x); S[1] = S[1] * da[i][1] + bfhi(uv[i].x); S[2] = S[2] * da[i][2] + bflo(uv[i].y); S[3] = S[3] * da[i][3] + bfhi(uv[i].y);
                S[4] = S[4] * db[i][0] + bflo(uv[i].z); S[5] = S[5] * db[i][1] + bfhi(uv[i].z); S[6] = S[6] * db[i][2] + bflo(uv[i].w); S[7] = S[7] * db[i][3] + bfhi(uv[i].w);
            }
        }
    }
}

__device__ __forceinline__ void gla_g3(const Args& a, LAS unsigned char* lds, int o) {
    const int tid = otid(), lane = tid & 63, wid = __builtin_amdgcn_readfirstlane(tid >> 6), r32 = lane & 31, hi = lane >> 5;
    const int kd = tid & 127, part = tid >> 7;
    unsigned char* wsl = optr(a.ws); unsigned char* outl = (unsigned char*)optr(a.out);
    const bf16* PROJ = (const bf16*)(wsl + WS_R); bf16* GO = (bf16*)(wsl + WS_CAT);
    const bf16* wupT = (const bf16*)(wsl + WS_WUPT) + (size_t)o * 512 * 16; const float* bgk = a.in[12] + o * 512;
    const float* gnorm = a.in[13] + o * 1024;
    LAS float* ssq = (LAS float*)(lds + GL_SSQ);
    for (int unit = blockIdx.x; unit < 2048; unit += gridDim.x) {
        const int c = unit & 127, h = (unit >> 7) & 3, b = unit >> 9;
        const size_t tok0 = (size_t)b * SEQ + (size_t)c * 64;
        gla_stage(lds, PROJ, tok0, h, tid, true);
        bf16x8 sfr[4][2]; u32x2 gvr[2][4];
        {
            const bf16* sb0 = gla_ubase(outl, unit);
#pragma unroll
            for (int kb = 0; kb < 4; ++kb)
#pragma unroll
                for (int s2 = 0; s2 < 2; ++s2) sfr[kb][s2] = gld((const bf16x8*)(sb0 + ((size_t)((kb * 8 + wid) * 2 + s2) * 64 + lane) * 8));
#pragma unroll
            for (int ib = 0; ib < 2; ++ib)
#pragma unroll
                for (int q = 0; q < 4; ++q) gvr[ib][q] = gld((const u32x2*)(PROJ + (tok0 + 32 * ib + r32) * GLA_NP + 2048 + h * 256 + 32 * wid + 8 * q + 4 * hi));
        }
        __syncthreads();
        float bpre[16], blast;
        gla_gate(lds, wupT, bgk, h, kd, part, tid, bpre, blast);
        {
            const LAS unsigned short* qp = (const LAS unsigned short*)(lds + GL_QR + (16 * part) * 256) + kd;
            const LAS unsigned short* kp = (const LAS unsigned short*)(lds + GL_KR + (16 * part) * 256) + kd;
#pragma unroll
            for (int i = 0; i < 16; ++i) {
                const float qv = bf2f(qp[i * 128]) * 0.08838834764831845f * __expf(bpre[i]);
                const float kv = bf2f(kp[i * 128]) * __expf(-bpre[i]);
                *(LAS unsigned short*)(lds + GL_A + (16 * part + i) * GL_QP + kd * 2) = (unsigned short)f2bf(qv);
                *(LAS unsigned short*)(lds + GL_KT + (16 * part + i) * GL_QP + kd * 2) = (unsigned short)f2bf(kv);
            }
        }
        __syncthreads();
        bf16x8 pf[3][2];
#pragma unroll
        for (int blk = 0; blk < 3; ++blk) {
            const int jb = (blk == 2) ? 1 : 0, ib = (blk >= 1) ? 1 : 0;
            f32x16 x;
#pragma unroll
            for (int r = 0; r < 16; ++r) x[r] = 0.f;
#pragma unroll
            for (int ks = 0; ks < 8; ++ks) {
                const bf16x8 af = *(const LAS bf16x8*)(lds + GL_KT + (32 * jb + r32) * GL_QP + (16 * ks + 8 * hi) * 2);
                const bf16x8 bq = *(const LAS bf16x8*)(lds + GL_A + (32 * ib + r32) * GL_QP + (16 * ks + 8 * hi) * 2);
                x = MFMA32(af, bq, x);
            }
            if (jb == ib) {
#pragma unroll
                for (int r = 0; r < 16; ++r) if (crow(r, hi) > r32) x[r] = 0.f;
            }
            pf[blk][0] = pack8(x[0], x[1], x[2], x[3], x[4], x[5], x[6], x[7]);
            pf[blk][1] = pack8(x[8], x[9], x[10], x[11], x[12], x[13], x[14], x[15]);
        }
        f32x16 oa[2];
#pragma unroll
        for (int r = 0; r < 16; ++r) { oa[0][r] = 0.f; oa[1][r] = 0.f; }
        const bf16* sb = gla_ubase(outl, unit);
#pragma unroll
        for (int kb = 0; kb < 4; ++kb)
#pragma unroll
            for (int s2 = 0; s2 < 2; ++s2) {
                const bf16x8 sf = sfr[kb][s2];
#pragma unroll
                for (int ib = 0; ib < 2; ++ib) {
                    const LAS unsigned char* qa = lds + GL_A + (32 * ib + r32) * GL_QP + (32 * kb + 16 * s2 + 4 * hi) * 2;
                    const u32x2 lo = *(const LAS u32x2*)qa, hh = *(const LAS u32x2*)(qa + 16);
                    const u32x4 qq = {lo.x, lo.y, hh.x, hh.y};
                    oa[ib] = MFMA32(sf, __builtin_bit_cast(bf16x8, qq), oa[ib]);
                }
            }
        const LAS unsigned char* vbp = lds + GL_V + (4 * hi + ((lane >> 2) & 3)) * GL_VP + (32 * wid + 16 * ((lane >> 4) & 1) + 4 * (lane & 3)) * 2;
#pragma unroll
        for (int blk = 0; blk < 3; ++blk) {
            const int jb = (blk == 2) ? 1 : 0, ib = (blk >= 1) ? 1 : 0;
#pragma unroll
            for (int s2 = 0; s2 < 2; ++s2) {
                const v4i16_t lo = trrd(vbp + (32 * jb + 16 * s2) * GL_VP), hh = trrd(vbp + (32 * jb + 16 * s2 + 8) * GL_VP);
                oa[ib] = MFMA32(cat44(lo, hh), pf[blk][s2], oa[ib]);
            }
        }
        float ss0 = 0.f, ss1 = 0.f;
#pragma unroll
        for (int r = 0; r < 16; ++r) { ss0 += oa[0][r] * oa[0][r]; ss1 += oa[1][r] * oa[1][r]; }
        ss0 += __shfl_xor(ss0, 32); ss1 += __shfl_xor(ss1, 32);
        if (hi == 0) { ssq[wid * 64 + r32] = ss0; ssq[wid * 64 + 32 + r32] = ss1; }
        __syncthreads();
#pragma unroll
        for (int ib = 0; ib < 2; ++ib) {
            const int tok = 32 * ib + r32; float tsum = 0.f;
#pragma unroll
            for (int w = 0; w < 8; ++w) tsum += ssq[w * 64 + tok];
            const float rs = rsqrtf(tsum * (1.0f / 256.0f) + RMS_EPS);
            const bf16* gp = PROJ + (tok0 + tok) * GLA_NP + 2048 + h * 256;
            bf16* op = GO + (tok0 + tok) * 1024 + h * 256;
#pragma unroll
            for (int q = 0; q < 4; ++q) {
                const int v0 = 32 * wid + 8 * q + 4 * hi;
                const u32x2 gv = gvr[ib][q];
                const f32x4 gn = *(const f32x4*)(gnorm + h * 256 + v0);
                const float g0 = bflo(gv.x), g1 = bfhi(gv.x), g2 = bflo(gv.y), g3 = bfhi(gv.y);
                const float o0 = oa[ib][4 * q] * rs * gn[0] * (g0 / (1.0f + __expf(-g0)));
                const float o1 = oa[ib][4 * q + 1] * rs * gn[1] * (g1 / (1.0f + __expf(-g1)));
                const float o2 = oa[ib][4 * q + 2] * rs * gn[2] * (g2 / (1.0f + __expf(-g2)));
                const float o3 = oa[ib][4 * q + 3] * rs * gn[3] * (g3 / (1.0f + __expf(-g3)));
                u32x2 w; w.x = pk2(o0, o1); w.y = pk2(o2, o3);
                *(u32x2*)(op + v0) = w;
            }
        }
        __syncthreads();
    }
}

#define XB_TMO      128
#define XB_XCNT(j)  (256  + 64 * (j))
#define XB_XSUB(j)  (1280 + 64 * (j))
#define XB_XGEN(j)  (2304 + 64 * (j))
#define XB_TOP      3328
#define XB_TOPGEN   3392
#define XCD_BAR_WORDS 3456
#define XB_SPIN_CAP (1u << 18)

__device__ __forceinline__ unsigned xb_ld(unsigned* p)              { return __hip_atomic_load(p, __ATOMIC_RELAXED, __HIP_MEMORY_SCOPE_AGENT); }
__device__ __forceinline__ unsigned xb_add(unsigned* p, unsigned v) { return __hip_atomic_fetch_add(p, v, __ATOMIC_RELAXED, __HIP_MEMORY_SCOPE_AGENT); }
__device__ __forceinline__ unsigned xb_xcc_id() { return (unsigned)__builtin_amdgcn_s_getreg((3 << 11) | 20) & 0xFu; }
#define XB_SPIN(cond, bar) do { unsigned _sp = 0; while (cond) { __builtin_amdgcn_s_sleep(1); \
    if ((++_sp & 255u) == 0u) { if (xb_ld(&(bar)[XB_TMO])) break; if (_sp > XB_SPIN_CAP) { atomicAdd(&(bar)[XB_TMO], 1u); break; } } } } while (0)

struct XcdBarrier {
    unsigned* bar; unsigned x;
    volatile LAS unsigned* st;
};

__device__ __forceinline__ XcdBarrier xcd_barrier_post(unsigned* bar, volatile LAS unsigned* st) {
    XcdBarrier b; b.bar = bar; b.x = xb_xcc_id(); b.st = st;
    if (threadIdx.x == 0) (void)xb_add(&bar[XB_XCNT(b.x)], 1u);
    return b;
}
__device__ __forceinline__ void xcd_barrier_complete(unsigned* bar, unsigned x, unsigned& nloc, unsigned& nx) {
    const unsigned G = gridDim.x * gridDim.y * gridDim.z;
    unsigned sum, cnt, mine, sp = 0u;
    for (;;) {
        sum = 0u; cnt = 0u; mine = 0u;
#pragma unroll
        for (unsigned j = 0; j < 16; ++j) { const unsigned c = xb_ld(&bar[XB_XCNT(j)]); sum += c; cnt += (c > 0u) ? 1u : 0u; mine = (j == x) ? c : mine; }
        if (sum == G) break;
        __builtin_amdgcn_s_sleep(1);
        if ((++sp & 255u) == 0u) { if (xb_ld(&bar[XB_TMO])) break; if (sp > XB_SPIN_CAP) { atomicAdd(&bar[XB_TMO], 1u); break; } }
    }
    nloc = mine > 0u ? mine : 1u; nx = cnt > 0u ? cnt : 1u;
}

__device__ __forceinline__ void xcd_barrier(const XcdBarrier& b) {
    asm volatile("s_waitcnt vmcnt(0)" ::: "memory");
    __syncthreads();
    if (threadIdx.x == 0) {
        unsigned* bar = b.bar;
        __builtin_amdgcn_s_waitcnt(0);
        unsigned nloc = b.st[0], nx = b.st[1];
        if (nloc == 0u) { xcd_barrier_complete(bar, b.x, nloc, nx); b.st[0] = nloc; b.st[1] = nx; }
        const unsigned old = xb_add(&bar[XB_XSUB(b.x)], 1u);
        const unsigned gen = old / nloc;
        if (old + 1u == (gen + 1u) * nloc) {
            __builtin_amdgcn_fence(__ATOMIC_RELEASE, "agent");
            asm volatile("s_waitcnt vmcnt(0)" ::: "memory");
            const unsigned og = xb_add(&bar[XB_TOP], 1u);
            const unsigned tg = og / nx;
            if (og + 1u == (tg + 1u) * nx) xb_add(&bar[XB_TOPGEN], 1u);
            else XB_SPIN(xb_ld(&bar[XB_TOPGEN]) == tg, bar);
            __builtin_amdgcn_fence(__ATOMIC_ACQUIRE, "agent");
            xb_add(&bar[XB_XGEN(b.x)], 1u);
            asm volatile("s_waitcnt vmcnt(0)" ::: "memory");
        } else {
            XB_SPIN(xb_ld(&bar[XB_XGEN(b.x)]) == gen, bar);
            __builtin_amdgcn_fence(__ATOMIC_ACQUIRE, "agent");
            asm volatile("s_waitcnt vmcnt(0)" ::: "memory");
        }
    }
    __syncthreads();
}

__global__ void __launch_bounds__(512, 2) mega_fwd(Args a) {
    extern __shared__ __attribute__((aligned(16))) unsigned char lds_raw[];
    LAS unsigned char* lds = (LAS unsigned char*)lds_raw;
    cg::grid_group grid = cg::this_grid();
    if (threadIdx.x < 2) *(volatile LAS unsigned*)(lds + LDS_BARST + 4 * threadIdx.x) = 0u;
    __syncthreads();
    if (a.ph_lo < 0) grid.sync();
    XcdBarrier bar = xcd_barrier_post((unsigned*)(a.ws + WS_CTL), (volatile LAS unsigned*)(lds + LDS_BARST));
    unsigned char* ws = a.ws;
    float* ssq = (float*)(ws + WS_SSQ);
    bf16* XB = (bf16*)(ws + WS_XB); bf16* CAT = (bf16*)(ws + WS_CAT); bf16* R = (bf16*)(ws + WS_R);
#ifndef EXTRA_SYNCS
#define EXTRA_SYNCS 0
#endif
    for (int es = 0; es < EXTRA_SYNCS; ++es) xcd_barrier(bar);
#ifndef REPEAT_MASK
#define REPEAT_MASK 0u
#endif
    for (int step = a.ph_lo; step < a.ph_hi; ++step)
    for (int rep = 0, nrep = (((REPEAT_MASK >> step) & 1u) ? 2 : 1); rep < nrep; ++rep) {
        int layer, sub;
        if (step < 6) { layer = 0; sub = step - 1; } else if (step < 13) { layer = 1; sub = step - 6; } else if (step < 18) { layer = 2; sub = step - 13; } else { layer = 3; sub = step - 18; }
        const bool odd = layer & 1; const int nsub = odd ? 7 : 5;
#ifndef NO_PRO
        if (step == 0) prologue(a, lds);
        else
#endif
        if (step == 25) final_norm(a);
        else if (sub == 0 || sub >= nsub - 3) {
            pg8::Gemm g; EpiX E; E.mode = 0; E.O = nullptr; E.ldc = 0; E.ssq_in = nullptr; E.base = nullptr; E.xout = nullptr; E.ssq_out = nullptr;
            const int half = layer >> 1;
            if (sub == 0) {
                g.A = XB; g.M = T_TOK; g.K = 1024;
                if (!odd) { g.Bt = (const bf16*)(ws + WS_WAB_IN) + (size_t)half * 2048 * 1024; g.N = AB_N; } else { g.Bt = (const bf16*)(ws + WS_WGLA_IN) + (size_t)half * GLA_NP * 1024; g.N = GLA_NP; }
                E.mode = 0; E.O = R; E.ldc = g.N; E.ssq_in = ssq + (size_t)((2 * layer) & 1) * T_TOK * 16;
            } else if (sub == nsub - 3) {
                g.A = CAT; g.M = T_TOK; g.K = 1024; g.N = 1024;
                g.Bt = (!odd ? (const bf16*)(ws + WS_WAB_OUT) : (const bf16*)(ws + WS_WGLA_OUT)) + (size_t)half * 1024 * 1024;
                E.mode = 2; E.O = XB; E.ldc = 1024; E.base = (layer == 0) ? a.in[0] : a.out; E.xout = a.out; E.ssq_out = ssq + (size_t)((2 * layer + 1) & 1) * T_TOK * 16;
            } else if (sub == nsub - 2) {
                g.A = XB; g.M = T_TOK; g.K = 1024; g.N = DFF; g.Bt = (const bf16*)(ws + WS_W1) + (size_t)layer * 4096 * 1024;
                E.mode = 1; E.O = R; E.ldc = DFF; E.ssq_in = ssq + (size_t)((2 * layer + 1) & 1) * T_TOK * 16;
            } else {
                g.A = R; g.M = T_TOK; g.K = DFF; g.N = 1024; g.Bt = (const bf16*)(ws + WS_W2) + (size_t)layer * 1024 * 4096;
                E.mode = 2; E.O = XB; E.ldc = 1024; E.base = a.out; E.xout = a.out; E.ssq_out = ssq + (size_t)((2 * layer + 2) & 1) * T_TOK * 16;
            }
            pg8::StaticOrder S; S.init(g.M, g.N, (int)gridDim.x, (int)blockIdx.x);
#ifndef NO_GEMM
            pg8::gemm_phase<EpiX, pg8::StaticOrder, true, true>(lds, g, S, E);
#endif
        }
#ifndef NO_ATTN
        else if (!odd) attn_phase(a, lds, layer);
#endif
#ifndef NO_G1
        else if (sub == 1) gla_g1(a, lds, layer >> 1);
#endif
#ifndef NO_G2
        else if (sub == 2) gla_g2(a);
#endif
#ifndef NO_G3
        else if (sub == 3) gla_g3(a, lds, layer >> 1);
#endif
        if (step + 1 < a.ph_hi || rep + 1 < nrep) {
            xcd_barrier(bar);
        }
    }
}

#ifndef N_LAUNCH_SPLIT
#define N_LAUNCH_SPLIT 0
#endif
extern "C" void kernel_launch(void* const* d_in, const int* in_sizes, int n_in, void* d_out, int out_size, void* d_ws, size_t ws_size, hipStream_t stream) {
    static int grid = 0;
    if (grid == 0) {
        if (n_in != 17 || out_size != T_TOK * DM || ws_size < WS_END) { fprintf(stderr, "kernel_launch: unexpected shapes / workspace (%d inputs, out %d, ws %zu)\n", n_in, out_size, ws_size); grid = -1; return; }
        int dev = 0, cus = 0, per_cu = 0;
        hipGetDevice(&dev);
        hipDeviceGetAttribute(&cus, hipDeviceAttributeMultiprocessorCount, dev);
        if (hipFuncSetAttribute((const void*)mega_fwd, hipFuncAttributeMaxDynamicSharedMemorySize, LDS_BYTES) != hipSuccess) { fprintf(stderr, "kernel_launch: hipFuncSetAttribute failed\n"); grid = -1; return; }
        if (hipOccupancyMaxActiveBlocksPerMultiprocessor(&per_cu, (const void*)mega_fwd, 512, LDS_BYTES) != hipSuccess || per_cu < 1) per_cu = 1;
        (void)hipGetLastError();
        grid = cus * per_cu;
        if (grid > 256) grid = 256;
    }
    if (grid < 0) return;
    if (hipMemsetAsync((char*)d_ws + WS_CTL, 0, CTL_BYTES, stream) != hipSuccess) { fprintf(stderr, "kernel_launch: memset failed\n"); return; }
    Args a{};
    for (int i = 0; i < 17; ++i) a.in[i] = (const float*)d_in[i];
    a.out = (float*)d_out; a.ws = (unsigned char*)d_ws;
#if N_LAUNCH_SPLIT
    for (int s = 0; s < NSTEPS; ++s) { a.ph_lo = s; a.ph_hi = s + 1; void* args[] = {&a};
        hipError_t e = hipLaunchCooperativeKernel((const void*)mega_fwd, dim3(grid), dim3(512), args, LDS_BYTES, stream);
        if (e != hipSuccess) { fprintf(stderr, "launch %d failed: %s\n", s, hipGetErrorString(e)); break; } }
#else
    a.ph_lo = 0; a.ph_hi = NSTEPS; void* args[] = {&a};
    hipError_t e = hipLaunchCooperativeKernel((const void*)mega_fwd, dim3(grid), dim3(512), args, LDS_BYTES, stream);
    if (e != hipSuccess) fprintf(stderr, "cooperative launch failed: %s (grid %d)\n", hipGetErrorString(e), grid);
#endif
}
```
